# Optimizing an MI355X kernel written in HIP

```python
import math
import jax, jax.numpy as jnp
from jax import lax
import numpy as np

D_MODEL = 2048
BATCH = 1
SEQ = 8192
DEPTH = 1
DEC_BATCH = 128
DEC_SEQ = 1
PAST_LEN = 8192
PAGE_SIZE = 128

HEAD_DIM = 64
N_HEADS = D_MODEL // HEAD_DIM
N_KV_HEADS = 4
GROUP = N_HEADS // N_KV_HEADS
Q_DIM = N_HEADS * HEAD_DIM
KV_DIM = N_KV_HEADS * HEAD_DIM
WINDOW = 128
ROPE_THETA = 10000.0
POOL_WINDOWS = (2, 4, 8, 16)
POOL_GROUPS = len(POOL_WINDOWS)
POOL_WIDTH = D_MODEL // 2
POOL_GROUP_DIM = POOL_WIDTH // POOL_GROUPS
POOL_HIST = max(POOL_WINDOWS) - 1
D_FF = 5632
CONV_W = 3
IN_DIM = Q_DIM + 2 * KV_DIM + POOL_WIDTH + 2 * D_MODEL
LN_EPS = 1e-5
NEG_INF = -1e30

kernel_name = "hybrid_pool_swa_sink_convffn_deepnorm_step"


def layer_norm(x, g, b):
    xf = x.astype(jnp.float32)
    mu = jnp.mean(xf, axis=-1, keepdims=True)
    var = jnp.mean(jnp.square(xf - mu), axis=-1, keepdims=True)
    return ((xf - mu) * lax.rsqrt(var + LN_EPS) * g.astype(jnp.float32) + b.astype(jnp.float32)).astype(x.dtype)


def rope(x, pos):
    half = HEAD_DIM // 2
    inv = ROPE_THETA ** (-jnp.arange(half, dtype=jnp.float32) / half)
    ang = pos.astype(jnp.float32)[:, None] * inv[None, :]
    cos = jnp.cos(ang)[:, None, :]
    sin = jnp.sin(ang)[:, None, :]
    x1 = x[..., :half].astype(jnp.float32)
    x2 = x[..., half:].astype(jnp.float32)
    return jnp.concatenate([x1 * cos - x2 * sin, x2 * cos + x1 * sin], axis=-1).astype(x.dtype)


def window_attention(q, k_ext, v_ext, pos0, sinks):
    N, T = q.shape[0], q.shape[1]
    blk = WINDOW if T % WINDOW == 0 else T
    nblk = T // blk
    qb = q.reshape(N, nblk, blk, N_KV_HEADS, GROUP, HEAD_DIM)
    if blk == WINDOW:
        kb = k_ext.reshape(N, nblk + 1, WINDOW, N_KV_HEADS, HEAD_DIM)
        vb = v_ext.reshape(N, nblk + 1, WINDOW, N_KV_HEADS, HEAD_DIM)
        kb = jnp.concatenate([kb[:, :-1], kb[:, 1:]], axis=2)
        vb = jnp.concatenate([vb[:, :-1], vb[:, 1:]], axis=2)
    else:
        kb = k_ext[:, None]
        vb = v_ext[:, None]
    q_pos = pos0 + jnp.arange(T).reshape(nblk, blk)
    k_pos = pos0 - WINDOW + jnp.arange(nblk)[:, None] * blk + jnp.arange(WINDOW + blk)[None, :]
    diff = q_pos[:, :, None] - k_pos[:, None, :]
    visible = (diff >= 0) & (diff < WINDOW) & (k_pos[:, None, :] >= 0)
    s = jnp.einsum('nbqkgd,nbskd->nbkgqs', qb, kb, preferred_element_type=jnp.float32) * (HEAD_DIM ** -0.5)
    s = jnp.where(visible[None, :, None, None], s, NEG_INF)
    sink = sinks.astype(jnp.float32).reshape(1, 1, N_KV_HEADS, GROUP, 1, 1)
    m = jnp.maximum(jnp.max(s, axis=-1, keepdims=True), sink)
    e = jnp.exp(s - m)
    p = e / (jnp.sum(e, axis=-1, keepdims=True) + jnp.exp(sink - m))
    o = jnp.einsum('nbkgqs,nbskd->nbqkgd', p.astype(v_ext.dtype), vb)
    return o.reshape(N, T, Q_DIM)


def pool_mix(u, hist, pos0, w_pool_mix, pool_scale):
    N, T = u.shape[0], u.shape[1]
    ext = jnp.concatenate([hist, u], axis=1).astype(jnp.float32)
    cs = jnp.pad(jnp.cumsum(ext, axis=1), ((0, 0), (1, 0), (0, 0)))
    pos = pos0 + jnp.arange(T)
    groups = []
    for g, w in enumerate(POOL_WINDOWS):
        sl = slice(g * POOL_GROUP_DIM, (g + 1) * POOL_GROUP_DIM)
        tot = cs[:, POOL_HIST + 1:POOL_HIST + 1 + T, sl] - cs[:, POOL_HIST + 1 - w:POOL_HIST + 1 - w + T, sl]
        cnt = jnp.minimum(w, pos + 1).astype(jnp.float32)[:, None]
        groups.append(tot / cnt - u[..., sl].astype(jnp.float32))
    d = jnp.stack(groups, axis=2).astype(u.dtype)
    y = jnp.einsum('ntgc,gcd->ntgd', d, w_pool_mix).reshape(N, T, POOL_WIDTH)
    return y * pool_scale


def causal_dwconv(g, hist, conv_w, conv_b):
    T = g.shape[1]
    ext = jnp.concatenate([hist, g], axis=1)
    y = conv_b + ext[:, 0:T] * conv_w[0]
    for j in range(1, CONV_W):
        y = y + ext[:, j:j + T] * conv_w[j]
    return y, ext[:, -(CONV_W - 1):]


def decoder_layer(x, hist_k, hist_v, hist_pool, hist_conv, pos0,
                  w_in, attn_sinks, w_pool_mix, pool_scale, w_attn_branch, w_pool_branch, w_out,
                  ln1_g, ln1_b, w_up, w_gate, conv_w, conv_b, w_down, ln2_g, ln2_b):
    N, T, _ = x.shape
    alpha = (2.0 * DEPTH) ** 0.25
    pos = pos0 + jnp.arange(T)
    proj = x @ w_in
    cuts = [Q_DIM, Q_DIM + KV_DIM, Q_DIM + 2 * KV_DIM, Q_DIM + 2 * KV_DIM + POOL_WIDTH,
            Q_DIM + 2 * KV_DIM + POOL_WIDTH + D_MODEL]
    q, k, v, u, gate_pool, gate_attn = jnp.split(proj, cuts, axis=-1)
    q = rope(q.reshape(N, T, N_HEADS, HEAD_DIM), pos)
    k = rope(k.reshape(N, T, N_KV_HEADS, HEAD_DIM), pos)
    v = v.reshape(N, T, N_KV_HEADS, HEAD_DIM)
    k_ext = jnp.concatenate([hist_k, k], axis=1)
    v_ext = jnp.concatenate([hist_v, v], axis=1)
    attn = window_attention(q, k_ext, v_ext, pos0, attn_sinks)
    pooled = pool_mix(u, hist_pool, pos0, w_pool_mix, pool_scale)
    new_pool = jnp.concatenate([hist_pool, u], axis=1)[:, -POOL_HIST:]
    merged = (jax.nn.sigmoid(gate_pool) * (pooled @ w_pool_branch)
              + jax.nn.sigmoid(gate_attn) * (attn @ w_attn_branch))
    x1 = layer_norm(alpha * x + merged @ w_out, ln1_g, ln1_b)
    gc, new_conv = causal_dwconv(x1 @ w_gate, hist_conv, conv_w, conv_b)
    ffn = (jax.nn.gelu(gc) * (x1 @ w_up)) @ w_down
    x2 = layer_norm(alpha * x1 + ffn, ln2_g, ln2_b)
    return x2, k_ext[:, -WINDOW:], v_ext[:, -WINDOW:], new_pool, new_conv


def setup_inputs(seed: int = 0) -> dict:
    key = jax.random.key(seed)
    ks = jax.random.split(key, 24)
    f32 = jnp.float32
    beta = (8.0 * DEPTH) ** -0.25
    nrm = lambda k, shape, scale: jax.random.normal(k, shape, f32) * scale
    col_scale = jnp.concatenate([jnp.ones((Q_DIM + KV_DIM,), f32), jnp.full((KV_DIM,), beta, f32),
                                 jnp.ones((POOL_WIDTH + 2 * D_MODEL,), f32)])
    return {
        'x_prompt': nrm(ks[0], (BATCH, SEQ, D_MODEL), 1.0),
        'x_sample': nrm(ks[1], (DEC_BATCH, DEC_SEQ, D_MODEL), 1.0),
        'cache_k': nrm(ks[2], (DEPTH, DEC_BATCH, WINDOW, N_KV_HEADS, HEAD_DIM), 1.0),
        'cache_v': nrm(ks[3], (DEPTH, DEC_BATCH, WINDOW, N_KV_HEADS, HEAD_DIM), beta),
        'state_pool': nrm(ks[4], (DEPTH, DEC_BATCH, POOL_HIST, POOL_WIDTH), 1.0),
        'state_conv': nrm(ks[5], (DEPTH, DEC_BATCH, CONV_W - 1, D_FF), 1.0),
        'w_in': nrm(ks[6], (DEPTH, D_MODEL, IN_DIM), D_MODEL ** -0.5) * col_scale,
        'attn_sinks': nrm(ks[7], (DEPTH, N_HEADS), 1.0),
        'w_pool_mix': nrm(ks[8], (DEPTH, POOL_GROUPS, POOL_GROUP_DIM, POOL_GROUP_DIM), POOL_GROUP_DIM ** -0.5),
        'pool_scale': 1.0 + nrm(ks[9], (DEPTH, POOL_WIDTH), 0.1),
        'w_attn_branch': nrm(ks[10], (DEPTH, Q_DIM, D_MODEL), Q_DIM ** -0.5),
        'w_pool_branch': nrm(ks[11], (DEPTH, POOL_WIDTH, D_MODEL), POOL_WIDTH ** -0.5),
        'w_out': nrm(ks[12], (DEPTH, D_MODEL, D_MODEL), beta * D_MODEL ** -0.5),
        'ln1_g': 1.0 + nrm(ks[13], (DEPTH, D_MODEL), 0.02),
        'ln1_b': nrm(ks[14], (DEPTH, D_MODEL), 0.02),
        'w_up': nrm(ks[15], (DEPTH, D_MODEL, D_FF), D_MODEL ** -0.5),
        'w_gate': nrm(ks[16], (DEPTH, D_MODEL, D_FF), D_MODEL ** -0.5),
        'conv_w': nrm(ks[17], (DEPTH, CONV_W, D_FF), CONV_W ** -0.5),
        'conv_b': nrm(ks[18], (DEPTH, D_FF), 0.01),
        'w_down': nrm(ks[19], (DEPTH, D_FF, D_MODEL), beta * D_FF ** -0.5),
        'ln2_g': 1.0 + nrm(ks[20], (DEPTH, D_MODEL), 0.02),
        'ln2_b': nrm(ks[21], (DEPTH, D_MODEL), 0.02),
    }


def reference(x_prompt, x_sample, cache_k, cache_v, state_pool, state_conv,
              w_in, attn_sinks, w_pool_mix, pool_scale, w_attn_branch, w_pool_branch, w_out,
              ln1_g, ln1_b, w_up, w_gate, conv_w, conv_b, w_down, ln2_g, ln2_b):
    B = x_prompt.shape[0]
    dt = x_prompt.dtype
    hp, hs = x_prompt, x_sample
    kp_l, vp_l, pp_l, cp_l, ks_l, vs_l, ps_l, cs_l = [], [], [], [], [], [], [], []
    for l in range(DEPTH):
        weights = (w_in[l], attn_sinks[l], w_pool_mix[l], pool_scale[l], w_attn_branch[l], w_pool_branch[l],
                   w_out[l], ln1_g[l], ln1_b[l], w_up[l], w_gate[l], conv_w[l], conv_b[l], w_down[l],
                   ln2_g[l], ln2_b[l])
        hp, kp, vp, pp, cp = decoder_layer(
            hp,
            jnp.zeros((B, WINDOW, N_KV_HEADS, HEAD_DIM), dt),
            jnp.zeros((B, WINDOW, N_KV_HEADS, HEAD_DIM), dt),
            jnp.zeros((B, POOL_HIST, POOL_WIDTH), dt),
            jnp.zeros((B, CONV_W - 1, D_FF), dt),
            0, *weights)
        hs, ksm, vsm, psm, csm = decoder_layer(
            hs, cache_k[l], cache_v[l], state_pool[l], state_conv[l], PAST_LEN, *weights)
        kp_l.append(kp); vp_l.append(vp); pp_l.append(pp); cp_l.append(cp)
        ks_l.append(ksm); vs_l.append(vsm); ps_l.append(psm); cs_l.append(csm)
    return (hp, hs,
            jnp.stack(kp_l), jnp.stack(vp_l), jnp.stack(pp_l), jnp.stack(cp_l),
            jnp.stack(ks_l), jnp.stack(vs_l), jnp.stack(ps_l), jnp.stack(cs_l))
```

```cpp
#include <hip/hip_runtime.h>
#include <hip/hip_cooperative_groups.h>
#include <cstdio>
#include <cstdint>
namespace cg = cooperative_groups;

#define LAS __attribute__((address_space(3)))
typedef unsigned short bf16_t;
typedef short bf16x8 __attribute__((ext_vector_type(8)));
typedef float f32x4 __attribute__((ext_vector_type(4)));
typedef float f32x2 __attribute__((ext_vector_type(2)));
typedef float f32x16 __attribute__((ext_vector_type(16)));
typedef unsigned u32x4 __attribute__((ext_vector_type(4)));
typedef unsigned u32x2 __attribute__((ext_vector_type(2)));
typedef __bf16 bf16x2_t __attribute__((ext_vector_type(2)));
typedef _Float16 h2_t __attribute__((ext_vector_type(2)));

constexpr int DM = 2048, SEQ = 8192, NSMP = 128, MR = SEQ + NSMP  , MP = 8448  ;
constexpr int KVD = 256, PW = 1024, FF = 5632, IND = 7680, NH = 32, HD = 64;
constexpr float LN_EPS = 1e-5f;
constexpr float LOG2E = 1.4426950408889634f;
constexpr float QSCALE = 0.125f * LOG2E;
constexpr float ALPHA = 1.189207115002721f;

constexpr size_t O_Y = 0, O_KP = 17039360, O_VP = 17072128, O_PP = 17104896, O_CP = 17120256, O_KS = 17131520, O_VS = 21325824, O_PS = 25520128, O_CS = 27486208;

constexpr size_t MiB = 1u << 20;
constexpr size_t WS_WGU = 0, WS_WD = 44 * MiB, WS_R1 = 66 * MiB  , WS_EARLY = 99 * MiB;
constexpr size_t WS_WIN = WS_EARLY, WS_WAB = WS_WIN + 30 * MiB, WS_WPB = WS_WAB + 8 * MiB, WS_WMIX = WS_WPB + 4 * MiB, WS_WO = WS_WMIX + 1 * MiB;
constexpr size_t WS_R2 = WS_WO + 8 * MiB  , WS_U = WS_R2 + 33 * MiB, WS_SG = WS_U + 33 * MiB  , WS_KB = WS_SG + 66 * MiB, WS_VB = WS_KB + 5 * MiB;
constexpr size_t WS_DP = WS_VB + 5 * MiB  , WS_PY = WS_DP + 33 * MiB  , WS_COS = WS_PY + 8 * MiB, WS_SIN = WS_COS + 2 * MiB, WS_END = WS_SIN + 2 * MiB;
constexpr size_t WS_GU = WS_EARLY;
static_assert(WS_END == 337 * MiB, "ws map");
constexpr size_t WS_CTL = WS_END, CTL_BYTES = 262144, CTL_PAD_BYTES = 524288, WS_TOTAL = WS_CTL + CTL_BYTES + CTL_PAD_BYTES;
constexpr int CW_RS1 = 4096, CW_RS2 = 21504, CW_CNT = 38912, CW_TS1 = 49152, CW_TS2 = 53248;
static_assert((CW_TS2 + 4096) * 4 <= (int)CTL_BYTES, "ctl map 2");
constexpr int CW_PS1 = 65536, CW_PS2 = 131072;
static_assert((CW_CNT + 6400) * 4 <= (int)CTL_BYTES && CW_RS1 + 2 * 8320 <= CW_RS2 && CW_RS2 + 2 * 8320 <= CW_CNT, "ctl map");
static_assert(WS_GU + (size_t)MP * 2 * FF * 2 <= WS_END, "GU overlay");

constexpr int LDS_BYTES = 147456;

__device__ __forceinline__ int lane_fresh() { int l; asm volatile("v_mbcnt_lo_u32_b32 %0, -1, 0\n\tv_mbcnt_hi_u32_b32 %0, -1, %0" : "=v"(l)); return l; }
__device__ __forceinline__ unsigned cvtpk(float lo, float hi) { f32x2 v = {lo, hi}; bf16x2_t b = __builtin_convertvector(v, bf16x2_t); return __builtin_bit_cast(unsigned, b); }
__device__ __forceinline__ float bf2f(unsigned short h) { return __builtin_bit_cast(float, (unsigned)h << 16); }
__device__ __forceinline__ float bflo(unsigned w) { return __builtin_bit_cast(float, w << 16); }
__device__ __forceinline__ float bfhi(unsigned w) { return __builtin_bit_cast(float, w & 0xffff0000u); }
__device__ __forceinline__ unsigned pkh(float a, float b) { h2_t v = {(_Float16)a, (_Float16)b}; return __builtin_bit_cast(unsigned, v); }
__device__ __forceinline__ float hlo(unsigned w) { h2_t v = __builtin_bit_cast(h2_t, w); return (float)v.x; }
__device__ __forceinline__ float hhi(unsigned w) { h2_t v = __builtin_bit_cast(h2_t, w); return (float)v.y; }
__device__ __forceinline__ float sigmoidf_(float v) { return __builtin_amdgcn_rcpf(1.f + __builtin_amdgcn_exp2f(-1.4426950408889634f * v)); }

namespace pg8 {
constexpr int BM = 256, BK = 64, HALF = 128, HTB = HALF * BK * 2, STAGE_BYTES = 8 * HTB, NXCD = 8, WGM = 8;
__host__ __device__ __forceinline__ int lds_byte(int r, int c) { const int st = (r >> 4) * 2 + (c >> 5), rr = r & 15, cc = c & 31, ob = rr * 64 + cc * 2; return st * 1024 + (ob ^ (((ob >> 9) & 1) << 5)); }
__host__ __device__ __forceinline__ void stage_rc(int b, int& R, int& C) { const int st = b / 1024, sb = b % 1024, swz = sb ^ (((sb >> 9) & 1) << 5); R = (st >> 1) * 16 + swz / 64; C = (st & 1) * 32 + (swz % 64) / 2; }
__host__ __device__ __forceinline__ int perm32(int rho) { const int n = rho >> 4, i = rho & 15; return 8 * (i >> 2) + 4 * n + (i & 3); }
struct Unit { int pm, pn; };
struct Gemm { const bf16_t* A; const bf16_t* Bt; int K, lda, ldb, acol; };
struct StaticOrder {
    int nM, nN, nwg, G, c, wgm;
    __device__ void init(int M, int N, int G_, int c_, int wgm_ = WGM) { nM = M / BM; nN = N / BM; nwg = nM * nN; G = G_; c = c_; wgm = wgm_; }
    __device__ bool next(int i, Unit& u) const {
        const long L = (long)i * G + c; if (L >= nwg) return false;
        int wgid = (int)L; { const int q = nwg / NXCD, r = nwg % NXCD, xcd = wgid % NXCD, off = wgid / NXCD; wgid = (xcd < r ? xcd * (q + 1) : r * (q + 1) + (xcd - r) * q) + off; }
        const int nig = wgm * nN, gid = wgid / nig, fm = gid * wgm, gsz = (nM - fm) < wgm ? (nM - fm) : wgm;
        u.pm = fm + ((wgid % nig) % gsz); u.pn = (wgid % nig) / gsz; return true;
    }
};
template <class Epi>
__device__ __forceinline__ void gemm_phase(LAS unsigned char* lds, const Gemm g, const StaticOrder& S, const Epi& E, int wid) {
    const int lane = lane_fresh(), tid = wid * 64 + lane, wr = wid >> 2, wc = wid & 3, fr = lane & 15, fq = lane >> 4;
    int K = g.K; asm volatile("" : "+s"(K));
    const int nt = K / BK;
    unsigned voffA[2], voffB[2];
#pragma unroll
    for (int i = 0; i < 2; ++i) { int R, C; stage_rc(tid * 16 + i * 8192, R, C); const int Rb = Epi::PERM ? ((R & ~31) + perm32(R & 31)) : R;
        voffA[i] = (unsigned)(R * g.lda + C) * 2u; voffB[i] = (unsigned)(Rb * g.ldb + C) * 2u; }
    const size_t kstep = (size_t)(BK * 2);
    const size_t hsA = (size_t)HALF * g.lda * 2, hsB = (size_t)HALF * g.ldb * 2;
    const unsigned ldsw = (unsigned)wid * 1024u;
    const int aoff = lds_byte(wr * 64 + fr, fq * 8), boff = lds_byte(wc * 32 + fr, fq * 8);
#define PG8_SA(b, h) (((b) * 2 + (h)) * HTB)
#define PG8_SB(b, h) ((4 + (b) * 2 + (h)) * HTB)
#define PG8_STAGE(bufoff, gbase, voff) do { _Pragma("unroll") for (int _i = 0; _i < 2; ++_i) \
        __builtin_amdgcn_global_load_lds((const unsigned*)((const char*)(gbase) + (voff)[_i]), (LAS unsigned*)(lds + (bufoff) + ldsw + _i * 8192), 16, 0, 0); } while (0)
#define PG8_LDA(dst, b, h) do { _Pragma("unroll") for (int m = 0; m < 4; ++m) _Pragma("unroll") for (int k = 0; k < 2; ++k) dst[m][k] = *(const LAS bf16x8*)(lds + PG8_SA(b, h) + aoff + m * 2048 + k * 1024); } while (0)
#define PG8_LDB(dst, b, h) do { _Pragma("unroll") for (int n = 0; n < 2; ++n) _Pragma("unroll") for (int k = 0; k < 2; ++k) dst[n][k] = *(const LAS bf16x8*)(lds + PG8_SB(b, h) + boff + n * 2048 + k * 1024); } while (0)
#define PG8_MMA(ai, bj, At, Bt) do { __builtin_amdgcn_s_setprio(1); _Pragma("unroll") for (int m = 0; m < 4; ++m) _Pragma("unroll") for (int n = 0; n < 2; ++n) _Pragma("unroll") for (int k = 0; k < 2; ++k) \
        acc[ai][bj][m][n] = __builtin_amdgcn_mfma_f32_16x16x32_bf16(Bt[n][k], At[m][k], acc[ai][bj][m][n], 0, 0, 0); __builtin_amdgcn_s_setprio(0); } while (0)
#define PG8_WAIT_V(n) asm volatile("s_waitcnt vmcnt(" #n ")" ::: "memory")
#define PG8_WAIT_L(n) asm volatile("s_waitcnt lgkmcnt(" #n ")" ::: "memory")
#define PG8_BAR __builtin_amdgcn_s_barrier()
#define PG8_SCHED __builtin_amdgcn_sched_barrier(0)
    Unit cur, nxt; int ui = 0;
    if (!S.next(0, cur)) return;
    f32x4 acc[2][2][4][2];
#pragma unroll
    for (int a = 0; a < 2; ++a)
#pragma unroll
        for (int b = 0; b < 2; ++b)
#pragma unroll
            for (int m = 0; m < 4; ++m)
#pragma unroll
                for (int n = 0; n < 2; ++n) acc[a][b][m][n] = (f32x4){0.f, 0.f, 0.f, 0.f};
    bf16x8 At[4][2], B0[2][2], B1[2][2];
    const char* cA = (const char*)g.A + (size_t)cur.pm * 2 * hsA + (size_t)cur.pn * g.acol * 2; const char* cB = (const char*)g.Bt + (size_t)cur.pn * 2 * hsB;
    PG8_STAGE(PG8_SB(0, 0), cB, voffB); PG8_STAGE(PG8_SB(0, 1), cB + hsB, voffB); PG8_STAGE(PG8_SA(0, 0), cA, voffA); PG8_STAGE(PG8_SA(0, 1), cA + hsA, voffA);
    if (wr == 1) PG8_BAR;
    PG8_WAIT_V(2); PG8_BAR;
    PG8_STAGE(PG8_SB(1, 0), cB + kstep, voffB); PG8_STAGE(PG8_SA(1, 0), cA + kstep, voffA); PG8_STAGE(PG8_SB(1, 1), cB + hsB + kstep, voffB);
    PG8_WAIT_V(6); PG8_BAR;
    for (;;) {
        const bool has_next = S.next(ui + 1, nxt);
        const char* nA = has_next ? (const char*)g.A + (size_t)nxt.pm * 2 * hsA + (size_t)nxt.pn * g.acol * 2 : cA; const char* nB = has_next ? (const char*)g.Bt + (size_t)nxt.pn * 2 * hsB : cB;
        for (int t = 0; t < nt; t += 2) {
            const bool last = (t == nt - 2);
            const char* a1 = cA + (size_t)(t + 1) * kstep;
            const char* a2 = last ? nA : cA + (size_t)(t + 2) * kstep; const char* b2 = last ? nB : cB + (size_t)(t + 2) * kstep;
            const char* a3 = a2 + kstep; const char* b3 = b2 + kstep;
            PG8_LDB(B0, 0, 0); PG8_LDB(B1, 0, 1); PG8_SCHED; PG8_LDA(At, 0, 0); PG8_STAGE(PG8_SA(1, 1), a1 + hsA, voffA);
            PG8_WAIT_V(8); PG8_WAIT_L(0); PG8_BAR; PG8_MMA(0, 0, At, B0); PG8_MMA(0, 1, At, B1); PG8_BAR; PG8_SCHED;
            PG8_LDA(At, 0, 1); PG8_STAGE(PG8_SB(0, 0), b2, voffB); PG8_STAGE(PG8_SB(0, 1), b2 + hsB, voffB); PG8_STAGE(PG8_SA(0, 0), a2, voffA);
            PG8_WAIT_V(8); PG8_WAIT_L(0); PG8_BAR; PG8_MMA(1, 0, At, B0); PG8_MMA(1, 1, At, B1); PG8_BAR; PG8_SCHED;
            PG8_LDB(B0, 1, 0); PG8_LDB(B1, 1, 1); PG8_SCHED; PG8_LDA(At, 1, 0); PG8_STAGE(PG8_SA(0, 1), a2 + hsA, voffA);
            PG8_WAIT_V(8); PG8_WAIT_L(0); PG8_BAR; PG8_MMA(0, 0, At, B0); PG8_MMA(0, 1, At, B1); PG8_BAR; PG8_SCHED;
            PG8_LDA(At, 1, 1); PG8_STAGE(PG8_SB(1, 0), b3, voffB); PG8_STAGE(PG8_SB(1, 1), b3 + hsB, voffB); PG8_STAGE(PG8_SA(1, 0), a3, voffA);
            PG8_WAIT_V(8); PG8_WAIT_L(0); PG8_BAR; PG8_MMA(1, 0, At, B0); PG8_MMA(1, 1, At, B1); PG8_BAR; PG8_SCHED;
        }
        if (wr == 0) PG8_BAR;
        E(acc, cur, wr, wc, fr, fq);
        if (!has_next) break;
#pragma unroll
        for (int a = 0; a < 2; ++a)
#pragma unroll
            for (int b = 0; b < 2; ++b)
#pragma unroll
                for (int m = 0; m < 4; ++m)
#pragma unroll
                    for (int n = 0; n < 2; ++n) acc[a][b][m][n] = (f32x4){0.f, 0.f, 0.f, 0.f};
        cur = nxt; cA = nA; cB = nB; ++ui;
        if (wr == 1) PG8_BAR;
    }
    PG8_WAIT_V(0);
    PG8_BAR;
#undef PG8_SA
#undef PG8_SB
#undef PG8_STAGE
#undef PG8_LDA
#undef PG8_LDB
#undef PG8_MMA
#undef PG8_WAIT_V
#undef PG8_WAIT_L
#undef PG8_BAR
#undef PG8_SCHED
}
template <class Epi>
__device__ __forceinline__ void gemm_phase2(LAS unsigned char* lds, const Gemm g, const Gemm g1, const StaticOrder& S, const Epi& E, int wid) {
    const int lane = lane_fresh(), tid = wid * 64 + lane, wr = wid >> 2, wc = wid & 3, fr = lane & 15, fq = lane >> 4;
    int K0 = g.K, K1 = g1.K; asm volatile("" : "+s"(K0), "+s"(K1));
    const int nt0 = K0 / BK, nt1 = K1 / BK;
    unsigned voffA[2], voffB[2];
#pragma unroll
    for (int i = 0; i < 2; ++i) { int R, C; stage_rc(tid * 16 + i * 8192, R, C); const int Rb = Epi::PERM ? ((R & ~31) + perm32(R & 31)) : R;
        voffA[i] = (unsigned)(R * g.lda + C) * 2u; voffB[i] = (unsigned)(Rb * g.ldb + C) * 2u; }
    const size_t kstep = (size_t)(BK * 2);
    const size_t hsA = (size_t)HALF * g.lda * 2, hsB = (size_t)HALF * g.ldb * 2;
    const unsigned ldsw = (unsigned)wid * 1024u;
    const int aoff = lds_byte(wr * 64 + fr, fq * 8), boff = lds_byte(wc * 32 + fr, fq * 8);
#define PG8_SA(b, h) (((b) * 2 + (h)) * HTB)
#define PG8_SB(b, h) ((4 + (b) * 2 + (h)) * HTB)
#define PG8_STAGE(bufoff, gbase, voff) do { _Pragma("unroll") for (int _i = 0; _i < 2; ++_i) \
        __builtin_amdgcn_global_load_lds((const unsigned*)((const char*)(gbase) + (voff)[_i]), (LAS unsigned*)(lds + (bufoff) + ldsw + _i * 8192), 16, 0, 0); } while (0)
#define PG8_LDA(dst, b, h) do { _Pragma("unroll") for (int m = 0; m < 4; ++m) _Pragma("unroll") for (int k = 0; k < 2; ++k) dst[m][k] = *(const LAS bf16x8*)(lds + PG8_SA(b, h) + aoff + m * 2048 + k * 1024); } while (0)
#define PG8_LDB(dst, b, h) do { _Pragma("unroll") for (int n = 0; n < 2; ++n) _Pragma("unroll") for (int k = 0; k < 2; ++k) dst[n][k] = *(const LAS bf16x8*)(lds + PG8_SB(b, h) + boff + n * 2048 + k * 1024); } while (0)
#define PG8_MMA(ai, bj, At, Bt) do { __builtin_amdgcn_s_setprio(1); _Pragma("unroll") for (int m = 0; m < 4; ++m) _Pragma("unroll") for (int n = 0; n < 2; ++n) _Pragma("unroll") for (int k = 0; k < 2; ++k) \
        acc[ai][bj][m][n] = __builtin_amdgcn_mfma_f32_16x16x32_bf16(Bt[n][k], At[m][k], acc[ai][bj][m][n], 0, 0, 0); __builtin_amdgcn_s_setprio(0); } while (0)
#define PG8_WAIT_V(n) asm volatile("s_waitcnt vmcnt(" #n ")" ::: "memory")
#define PG8_WAIT_L(n) asm volatile("s_waitcnt lgkmcnt(" #n ")" ::: "memory")
#define PG8_BAR __builtin_amdgcn_s_barrier()
#define PG8_SCHED __builtin_amdgcn_sched_barrier(0)
    Unit cur, nxt; int ui = 0;
    if (!S.next(0, cur)) return;
#define SEG_A(u_, sg_) ((const char*)((sg_) ? g1.A : g.A) + (size_t)(u_).pm * 2 * hsA)
#define SEG_B(u_, sg_) ((const char*)((sg_) ? g1.Bt : g.Bt) + (size_t)(u_).pn * 2 * hsB)
    f32x4 acc[2][2][4][2];
#pragma unroll
    for (int a = 0; a < 2; ++a)
#pragma unroll
        for (int b = 0; b < 2; ++b)
#pragma unroll
            for (int m = 0; m < 4; ++m)
#pragma unroll
                for (int n = 0; n < 2; ++n) acc[a][b][m][n] = (f32x4){0.f, 0.f, 0.f, 0.f};
    bf16x8 At[4][2], B0[2][2], B1[2][2];
    const char* cA = SEG_A(cur, 0); const char* cB = SEG_B(cur, 0);
    PG8_STAGE(PG8_SB(0, 0), cB, voffB); PG8_STAGE(PG8_SB(0, 1), cB + hsB, voffB); PG8_STAGE(PG8_SA(0, 0), cA, voffA); PG8_STAGE(PG8_SA(0, 1), cA + hsA, voffA);
    if (wr == 1) PG8_BAR;
    PG8_WAIT_V(2); PG8_BAR;
    PG8_STAGE(PG8_SB(1, 0), cB + kstep, voffB); PG8_STAGE(PG8_SA(1, 0), cA + kstep, voffA); PG8_STAGE(PG8_SB(1, 1), cB + hsB + kstep, voffB);
    PG8_WAIT_V(6); PG8_BAR;
    for (;;) {
        const int seg = ui & 1, nt = seg ? nt1 : nt0;
        bool has_next = true; nxt = cur; if (seg) has_next = S.next((ui + 1) >> 1, nxt);
        const char* nA = has_next ? SEG_A(nxt, seg ^ 1) : cA; const char* nB = has_next ? SEG_B(nxt, seg ^ 1) : cB;
        for (int t = 0; t < nt; t += 2) {
            const bool last = (t == nt - 2);
            const char* a1 = cA + (size_t)(t + 1) * kstep;
            const char* a2 = last ? nA : cA + (size_t)(t + 2) * kstep; const char* b2 = last ? nB : cB + (size_t)(t + 2) * kstep;
            const char* a3 = a2 + kstep; const char* b3 = b2 + kstep;
            PG8_LDB(B0, 0, 0); PG8_LDB(B1, 0, 1); PG8_SCHED; PG8_LDA(At, 0, 0); PG8_STAGE(PG8_SA(1, 1), a1 + hsA, voffA);
            PG8_WAIT_V(8); PG8_WAIT_L(0); PG8_BAR; PG8_MMA(0, 0, At, B0); PG8_MMA(0, 1, At, B1); PG8_BAR; PG8_SCHED;
            PG8_LDA(At, 0, 1); PG8_STAGE(PG8_SB(0, 0), b2, voffB); PG8_STAGE(PG8_SB(0, 1), b2 + hsB, voffB); PG8_STAGE(PG8_SA(0, 0), a2, voffA);
            PG8_WAIT_V(8); PG8_WAIT_L(0); PG8_BAR; PG8_MMA(1, 0, At, B0); PG8_MMA(1, 1, At, B1); PG8_BAR; PG8_SCHED;
            PG8_LDB(B0, 1, 0); PG8_LDB(B1, 1, 1); PG8_SCHED; PG8_LDA(At, 1, 0); PG8_STAGE(PG8_SA(0, 1), a2 + hsA, voffA);
            PG8_WAIT_V(8); PG8_WAIT_L(0); PG8_BAR; PG8_MMA(0, 0, At, B0); PG8_MMA(0, 1, At, B1); PG8_BAR; PG8_SCHED;
            PG8_LDA(At, 1, 1); PG8_STAGE(PG8_SB(1, 0), b3, voffB); PG8_STAGE(PG8_SB(1, 1), b3 + hsB, voffB); PG8_STAGE(PG8_SA(1, 0), a3, voffA);
            PG8_WAIT_V(8); PG8_WAIT_L(0); PG8_BAR; PG8_MMA(1, 0, At, B0); PG8_MMA(1, 1, At, B1); PG8_BAR; PG8_SCHED;
        }
        if (wr == 0) PG8_BAR;
        if (seg == 0) E.mid(acc, cur, wr, wc, fr, fq); else E(acc, cur, wr, wc, fr, fq);
        if (!has_next) break;
        if (seg)
#pragma unroll
        for (int a = 0; a < 2; ++a)
#pragma unroll
            for (int b = 0; b < 2; ++b)
#pragma unroll
                for (int m = 0; m < 4; ++m)
#pragma unroll
                    for (int n = 0; n < 2; ++n) acc[a][b][m][n] = (f32x4){0.f, 0.f, 0.f, 0.f};
        cur = nxt; cA = nA; cB = nB; ++ui;
        if (wr == 1) PG8_BAR;
    }
    PG8_WAIT_V(0);
    PG8_BAR;
#undef SEG_A
#undef SEG_B
#undef PG8_SA
#undef PG8_SB
#undef PG8_STAGE
#undef PG8_LDA
#undef PG8_LDB
#undef PG8_MMA
#undef PG8_WAIT_V
#undef PG8_WAIT_L
#undef PG8_BAR
#undef PG8_SCHED
}
}
using pg8::Unit;

#define ROW_OF(u, ai, wr, m, fr) ((u).pm * 256 + (ai) * 128 + (wr) * 64 + (m) * 16 + (fr))

struct EpiIn {
    static constexpr bool PERM = true;
    bf16_t* Q; bf16_t* Kb; bf16_t* Vb; float* U; unsigned short* SG; const float* COS; const float* SIN; float* out;
    __device__ __forceinline__ void operator()(const f32x4 (&acc)[2][2][4][2], const Unit& u, int wr, int wc, int fr, int fq) const {
        const int pn = u.pn;
        if (pn <= 8) {
            const float sc = pn < 8 ? QSCALE : 1.f;
            bf16_t* dst = pn < 8 ? Q : Kb; const int ld = pn < 8 ? DM : KVD; const int cb = (pn < 8 ? pn * 256 : 0) + 64 * wc + 8 * fq;
#pragma unroll
            for (int ai = 0; ai < 2; ++ai) {
                f32x4 tc0[4], tc1[4], ts0[4], ts1[4];
#pragma unroll
                for (int m = 0; m < 4; ++m) { const int r = ROW_OF(u, ai, wr, m, fr); const int pos = r < SEQ ? r : SEQ;
                    tc0[m] = *(const f32x4*)(COS + pos * 32 + 8 * fq); tc1[m] = *(const f32x4*)(COS + pos * 32 + 8 * fq + 4);
                    ts0[m] = *(const f32x4*)(SIN + pos * 32 + 8 * fq); ts1[m] = *(const f32x4*)(SIN + pos * 32 + 8 * fq + 4); }
#pragma unroll
                for (int m = 0; m < 4; ++m) {
                    const int r = ROW_OF(u, ai, wr, m, fr);
                    const f32x4 c0 = tc0[m], c1 = tc1[m], s0 = ts0[m], s1 = ts1[m];
                    const f32x4 a0 = acc[ai][0][m][0], a1 = acc[ai][0][m][1], b0 = acc[ai][1][m][0], b1 = acc[ai][1][m][1];
                    const f32x4 o10 = (a0 * c0 - b0 * s0) * sc, o11 = (a1 * c1 - b1 * s1) * sc, o20 = (b0 * c0 + a0 * s0) * sc, o21 = (b1 * c1 + a1 * s1) * sc;
                    u32x4 w1, w2; w1.x = cvtpk(o10[0], o10[1]); w1.y = cvtpk(o10[2], o10[3]); w1.z = cvtpk(o11[0], o11[1]); w1.w = cvtpk(o11[2], o11[3]);
                    w2.x = cvtpk(o20[0], o20[1]); w2.y = cvtpk(o20[2], o20[3]); w2.z = cvtpk(o21[0], o21[1]); w2.w = cvtpk(o21[2], o21[3]);
                    *(u32x4*)(dst + (size_t)r * ld + cb) = w1; *(u32x4*)(dst + (size_t)r * ld + cb + 32) = w2;
                    if (pn == 8) {
                        float* o = nullptr;
                        if (r >= SEQ - 128 && r < SEQ) o = out + O_KP + (size_t)(r - (SEQ - 128)) * 256 + cb;
                        else if (r >= SEQ && r < MR) o = out + O_KS + ((size_t)(r - SEQ) * 128 + 127) * 256 + cb;
                        if (o) { *(f32x4*)o = o10; *(f32x4*)(o + 4) = o11; *(f32x4*)(o + 32) = o20; *(f32x4*)(o + 36) = o21; }
                    }
                }
            }
        } else if (pn == 9) {
#pragma unroll
            for (int ai = 0; ai < 2; ++ai)
#pragma unroll
                for (int m = 0; m < 4; ++m) {
                    const int r = ROW_OF(u, ai, wr, m, fr);
                    float* o = nullptr;
                    if (r >= SEQ - 128 && r < SEQ) o = out + O_VP + (size_t)(r - (SEQ - 128)) * 256;
                    else if (r >= SEQ && r < MR) o = out + O_VS + ((size_t)(r - SEQ) * 128 + 127) * 256;
#pragma unroll
                    for (int bj = 0; bj < 2; ++bj) { const int c = 128 * bj + 32 * wc + 8 * fq; const f32x4 v0 = acc[ai][bj][m][0], v1 = acc[ai][bj][m][1];
                        u32x4 w; w.x = cvtpk(v0[0], v0[1]); w.y = cvtpk(v0[2], v0[3]); w.z = cvtpk(v1[0], v1[1]); w.w = cvtpk(v1[2], v1[3]);
                        *(u32x4*)(Vb + (size_t)r * KVD + c) = w;
                        if (o) { *(f32x4*)(o + c) = v0; *(f32x4*)(o + c + 4) = v1; } }
                }
        } else if (pn < 14) {
#pragma unroll
            for (int ai = 0; ai < 2; ++ai)
#pragma unroll
                for (int m = 0; m < 4; ++m) {
                    const int r = ROW_OF(u, ai, wr, m, fr);
                    float* o = nullptr;
                    if (r >= SEQ - 15 && r < SEQ) o = out + O_PP + (size_t)(r - (SEQ - 15)) * PW;
                    else if (r >= SEQ && r < MR) o = out + O_PS + ((size_t)(r - SEQ) * 15 + 14) * PW;
#pragma unroll
                    for (int bj = 0; bj < 2; ++bj) { const int c = (pn - 10) * 256 + 128 * bj + 32 * wc + 8 * fq; const f32x4 v0 = acc[ai][bj][m][0], v1 = acc[ai][bj][m][1];
                        *(f32x4*)(U + (size_t)r * PW + c) = v0; *(f32x4*)(U + (size_t)r * PW + c + 4) = v1;
                        if (o) { *(f32x4*)(o + c) = v0; *(f32x4*)(o + c + 4) = v1; } }
                }
        } else {
#pragma unroll
            for (int ai = 0; ai < 2; ++ai)
#pragma unroll
                for (int m = 0; m < 4; ++m) {
                    const int r = ROW_OF(u, ai, wr, m, fr);
#pragma unroll
                    for (int bj = 0; bj < 2; ++bj) { const int c = (pn - 14) * 256 + 128 * bj + 32 * wc + 8 * fq; const f32x4 v0 = acc[ai][bj][m][0], v1 = acc[ai][bj][m][1];
                        u32x4 w; w.x = pkh(sigmoidf_(v0[0]), sigmoidf_(v0[1])); w.y = pkh(sigmoidf_(v0[2]), sigmoidf_(v0[3])); w.z = pkh(sigmoidf_(v1[0]), sigmoidf_(v1[1])); w.w = pkh(sigmoidf_(v1[2]), sigmoidf_(v1[3]));
                        *(u32x4*)(SG + (size_t)r * 4096 + c) = w; }
                }
        }
    }
};
struct EpiMix {
    static constexpr bool PERM = true;
    bf16_t* PY; const float* scale;
    __device__ __forceinline__ void operator()(const f32x4 (&acc)[2][2][4][2], const Unit& u, int wr, int wc, int fr, int fq) const {
#pragma unroll
        for (int bj = 0; bj < 2; ++bj) { const int c = u.pn * 256 + 128 * bj + 32 * wc + 8 * fq; const f32x4 s0 = *(const f32x4*)(scale + c), s1 = *(const f32x4*)(scale + c + 4);
#pragma unroll
            for (int ai = 0; ai < 2; ++ai)
#pragma unroll
                for (int m = 0; m < 4; ++m) { const int r = ROW_OF(u, ai, wr, m, fr); const f32x4 v0 = acc[ai][bj][m][0] * s0, v1 = acc[ai][bj][m][1] * s1;
                    u32x4 w; w.x = cvtpk(v0[0], v0[1]); w.y = cvtpk(v0[2], v0[3]); w.z = cvtpk(v1[0], v1[1]); w.w = cvtpk(v1[2], v1[3]);
                    *(u32x4*)(PY + (size_t)r * PW + c) = w; } }
    }
};
struct EpiWeff {
    static constexpr bool PERM = true;
    bf16_t* W;
    __device__ __forceinline__ void operator()(const f32x4 (&acc)[2][2][4][2], const Unit& u, int wr, int wc, int fr, int fq) const {
#pragma unroll
        for (int bj = 0; bj < 2; ++bj) { const int c = u.pn * 256 + 128 * bj + 32 * wc + 8 * fq;
#pragma unroll
            for (int ai = 0; ai < 2; ++ai)
#pragma unroll
                for (int m = 0; m < 4; ++m) { const int r = ROW_OF(u, ai, wr, m, fr); const f32x4 v0 = acc[ai][bj][m][0], v1 = acc[ai][bj][m][1];
                    u32x4 w; w.x = cvtpk(v0[0], v0[1]); w.y = cvtpk(v0[2], v0[3]); w.z = cvtpk(v1[0], v1[1]); w.w = cvtpk(v1[2], v1[3]);
                    *(u32x4*)(W + (size_t)r * DM + c) = w; } }
    }
};
struct EpiBrA {
    static constexpr bool PERM = false;
    float* T1; const unsigned short* SG;
    __device__ __forceinline__ void operator()(const f32x4 (&acc)[2][2][4][2], const Unit& u, int wr, int wc, int fr, int fq) const {
#pragma unroll
        for (int ai = 0; ai < 2; ++ai)
#pragma unroll
            for (int m = 0; m < 4; ++m) { const int r = ROW_OF(u, ai, wr, m, fr); if (r < MR) {
#pragma unroll
                for (int bj = 0; bj < 2; ++bj)
#pragma unroll
                    for (int n = 0; n < 2; ++n) { const int c = u.pn * 256 + 128 * bj + 32 * wc + 16 * n + 4 * fq; const u32x2 gw = *(const u32x2*)(SG + (size_t)r * 4096 + c);
                        const f32x4 gt = {hlo(gw.x), hhi(gw.x), hlo(gw.y), hhi(gw.y)}; *(f32x4*)(T1 + (size_t)r * DM + c) = acc[ai][bj][m][n] * gt; } } }
    }
};
struct EpiBrB {
    static constexpr bool PERM = false;
    const float* T1; const unsigned short* SG; bf16_t* MG;
    __device__ __forceinline__ void operator()(const f32x4 (&acc)[2][2][4][2], const Unit& u, int wr, int wc, int fr, int fq) const {
#pragma unroll
        for (int ai = 0; ai < 2; ++ai)
#pragma unroll
            for (int m = 0; m < 4; ++m) { const int r = ROW_OF(u, ai, wr, m, fr);
#pragma unroll
                for (int bj = 0; bj < 2; ++bj)
#pragma unroll
                    for (int n = 0; n < 2; ++n) { const int c = u.pn * 256 + 128 * bj + 32 * wc + 16 * n + 4 * fq; f32x4 o = {0.f, 0.f, 0.f, 0.f};
                        if (r < MR) { const u32x2 gw = *(const u32x2*)(SG + (size_t)r * 4096 + 2048 + c); const f32x4 gt = {hlo(gw.x), hhi(gw.x), hlo(gw.y), hhi(gw.y)};
                            o = *(const f32x4*)(T1 + (size_t)r * DM + c) + acc[ai][bj][m][n] * gt; }
                        u32x2 w; w.x = cvtpk(o[0], o[1]); w.y = cvtpk(o[2], o[3]); *(u32x2*)(MG + (size_t)r * DM + c) = w; } }
    }
};
struct EpiBr {
    static constexpr bool PERM = false;
    const unsigned short* SG; bf16_t* MG;
    __device__ __forceinline__ void mid(f32x4 (&acc)[2][2][4][2], const Unit& u, int wr, int wc, int fr, int fq) const {
        unsigned o0 = (unsigned)((u.pm * 256 + wr * 64 + fr) * 4096 + u.pn * 256 + 32 * wc + 4 * fq) * 2u; asm volatile("" : "+v"(o0)); const char* sb = (const char*)SG;
#pragma unroll
        for (int ai = 0; ai < 2; ++ai) {
            u32x2 gp[4][2][2], ga[4][2][2];
#pragma unroll
            for (int m = 0; m < 4; ++m)
#pragma unroll
                for (int bj = 0; bj < 2; ++bj)
#pragma unroll
                    for (int n = 0; n < 2; ++n) { const unsigned o = o0 + (unsigned)(((ai * 128 + m * 16) * 4096 + 128 * bj + 16 * n) * 2); gp[m][bj][n] = *(const u32x2*)(sb + o); ga[m][bj][n] = *(const u32x2*)(sb + o + 4096); }
#pragma unroll
            for (int m = 0; m < 4; ++m)
#pragma unroll
                for (int bj = 0; bj < 2; ++bj)
#pragma unroll
                    for (int n = 0; n < 2; ++n) { const u32x2 p_ = gp[m][bj][n], q_ = ga[m][bj][n];
                        f32x4 rt; rt[0] = hlo(p_.x) * __builtin_amdgcn_rcpf(fmaxf(hlo(q_.x), 6.2e-5f)); rt[1] = hhi(p_.x) * __builtin_amdgcn_rcpf(fmaxf(hhi(q_.x), 6.2e-5f));
                        rt[2] = hlo(p_.y) * __builtin_amdgcn_rcpf(fmaxf(hlo(q_.y), 6.2e-5f)); rt[3] = hhi(p_.y) * __builtin_amdgcn_rcpf(fmaxf(hhi(q_.y), 6.2e-5f));
                        acc[ai][bj][m][n] = acc[ai][bj][m][n] * rt; }
            asm volatile("" : "+v"(acc[ai][0][0][0]), "+v"(acc[ai][0][0][1]), "+v"(acc[ai][1][0][0]), "+v"(acc[ai][1][0][1]), "+v"(acc[ai][0][1][0]), "+v"(acc[ai][0][1][1]), "+v"(acc[ai][1][1][0]), "+v"(acc[ai][1][1][1]),
                             "+v"(acc[ai][0][2][0]), "+v"(acc[ai][0][2][1]), "+v"(acc[ai][1][2][0]), "+v"(acc[ai][1][2][1]), "+v"(acc[ai][0][3][0]), "+v"(acc[ai][0][3][1]), "+v"(acc[ai][1][3][0]), "+v"(acc[ai][1][3][1]) :: "memory"); }
    }
    __device__ __forceinline__ void operator()(f32x4 (&acc)[2][2][4][2], const Unit& u, int wr, int wc, int fr, int fq) const {
        unsigned o0 = (unsigned)((u.pm * 256 + wr * 64 + fr) * 4096 + u.pn * 256 + 32 * wc + 4 * fq) * 2u; asm volatile("" : "+v"(o0)); const char* sb = (const char*)SG; char* mb = (char*)MG;
#pragma unroll
        for (int ai = 0; ai < 2; ++ai) {
            u32x2 ga[4][2][2];
#pragma unroll
            for (int m = 0; m < 4; ++m)
#pragma unroll
                for (int bj = 0; bj < 2; ++bj)
#pragma unroll
                    for (int n = 0; n < 2; ++n) { const unsigned o = o0 + (unsigned)(((ai * 128 + m * 16) * 4096 + 128 * bj + 16 * n) * 2); ga[m][bj][n] = *(const u32x2*)(sb + o + 4096); }
#pragma unroll
            for (int m = 0; m < 4; ++m)
#pragma unroll
                for (int bj = 0; bj < 2; ++bj)
#pragma unroll
                    for (int n = 0; n < 2; ++n) { const u32x2 q_ = ga[m][bj][n];
                        const f32x4 q = {fmaxf(hlo(q_.x), 6.2e-5f), fmaxf(hhi(q_.x), 6.2e-5f), fmaxf(hlo(q_.y), 6.2e-5f), fmaxf(hhi(q_.y), 6.2e-5f)};
                        const f32x4 v = acc[ai][bj][m][n] * q; u32x2 w; w.x = cvtpk(v[0], v[1]); w.y = cvtpk(v[2], v[3]);
                        const unsigned row = (unsigned)(u.pm * 256 + wr * 64 + fr + ai * 128 + m * 16), col = (unsigned)(u.pn * 256 + 32 * wc + 4 * fq + 128 * bj + 16 * n);
                        *(u32x2*)(mb + ((size_t)row * DM + col) * 2) = w; }
            asm volatile("" ::: "memory"); }
    }
};
struct EpiOut {
    static constexpr bool PERM = false;
    const float* xp; const float* xs; float* H1;
    __device__ __forceinline__ void operator()(const f32x4 (&acc)[2][2][4][2], const Unit& u, int wr, int wc, int fr, int fq) const {
#pragma unroll
        for (int ai = 0; ai < 2; ++ai)
#pragma unroll
            for (int m = 0; m < 4; ++m) { const int r = ROW_OF(u, ai, wr, m, fr); if (r < MR) { const float* xr = r < SEQ ? xp + (size_t)r * DM : xs + (size_t)(r - SEQ) * DM;
#pragma unroll
                for (int bj = 0; bj < 2; ++bj)
#pragma unroll
                    for (int n = 0; n < 2; ++n) { const int c = u.pn * 256 + 128 * bj + 32 * wc + 16 * n + 4 * fq;
                        *(f32x4*)(H1 + (size_t)r * DM + c) = *(const f32x4*)(xr + c) * ALPHA + acc[ai][bj][m][n]; } } }
    }
};

__device__ __forceinline__ void ln_tile(f32x4 (&v)[2][2][4][2], const Unit& u, int wr, int wc, int fr, int fq, LAS unsigned char* lx, float* rowstat, unsigned* cnt, unsigned want, const float* gam, const float* bet) {
    LAS f32x2* P = (LAS f32x2*)lx; LAS f32x2* S = (LAS f32x2*)(lx + 8192);
    const int tid = (wr * 4 + wc) * 64 + fq * 16 + fr;
#pragma unroll
    for (int ai = 0; ai < 2; ++ai)
#pragma unroll
        for (int m = 0; m < 4; ++m) { float s = 0.f, q = 0.f;
#pragma unroll
            for (int bj = 0; bj < 2; ++bj)
#pragma unroll
                for (int n = 0; n < 2; ++n) { const f32x4 x = v[ai][bj][m][n]; s += (x[0] + x[1]) + (x[2] + x[3]); q += (x[0] * x[0] + x[1] * x[1]) + (x[2] * x[2] + x[3] * x[3]); }
            s += __shfl_xor(s, 16); s += __shfl_xor(s, 32); q += __shfl_xor(q, 16); q += __shfl_xor(q, 32);
            if (fq == 0) P[(ai * 128 + wr * 64 + m * 16 + fr) * 4 + wc] = (f32x2){s, q}; }
    __syncthreads();
    if (tid < 256) { const f32x2 a = P[tid * 4 + 0], b = P[tid * 4 + 1], c = P[tid * 4 + 2], d = P[tid * 4 + 3];
        float* rs = rowstat + (size_t)(u.pm * 256 + tid) * 8;
        (void)__hip_atomic_fetch_add(rs, (a[0] + b[0]) + (c[0] + d[0]), __ATOMIC_RELAXED, __HIP_MEMORY_SCOPE_AGENT);
        (void)__hip_atomic_fetch_add(rs + 1, (a[1] + b[1]) + (c[1] + d[1]), __ATOMIC_RELAXED, __HIP_MEMORY_SCOPE_AGENT); }
    asm volatile("s_waitcnt vmcnt(0)" ::: "memory");
    __syncthreads();
    if (tid == 0) { (void)__hip_atomic_fetch_add(cnt, 1u, __ATOMIC_RELAXED, __HIP_MEMORY_SCOPE_AGENT);
        unsigned sp = 0; while (__hip_atomic_load(cnt, __ATOMIC_RELAXED, __HIP_MEMORY_SCOPE_AGENT) < want) { __builtin_amdgcn_s_sleep(1); if (++sp > (1u << 22)) break; }
        asm volatile("s_waitcnt vmcnt(0)" ::: "memory"); }
    __syncthreads();
    if (tid < 256) { float* rs = rowstat + (size_t)(u.pm * 256 + tid) * 8;
        const float sm = __hip_atomic_load(rs, __ATOMIC_RELAXED, __HIP_MEMORY_SCOPE_AGENT), sq = __hip_atomic_load(rs + 1, __ATOMIC_RELAXED, __HIP_MEMORY_SCOPE_AGENT);
        const float mean = sm * (1.f / DM), var = sq * (1.f / DM) - mean * mean; S[tid] = (f32x2){mean, 1.f / sqrtf(fmaxf(var, 0.f) + LN_EPS)}; }
    __syncthreads();
#pragma unroll
    for (int bj = 0; bj < 2; ++bj)
#pragma unroll
        for (int n = 0; n < 2; ++n) { const int c = u.pn * 256 + 128 * bj + 32 * wc + 16 * n + 4 * fq; const f32x4 g = *(const f32x4*)(gam + c), b = *(const f32x4*)(bet + c);
#pragma unroll
            for (int ai = 0; ai < 2; ++ai)
#pragma unroll
                for (int m = 0; m < 4; ++m) { const f32x2 st = S[ai * 128 + wr * 64 + m * 16 + fr]; v[ai][bj][m][n] = (v[ai][bj][m][n] - st[0]) * st[1] * g + b; } }
}
__device__ __forceinline__ unsigned tile_off0(const Unit& u, int wr, int wc, int fr, int fq) { unsigned o = (unsigned)((u.pm * 256 + wr * 64 + fr) * DM + u.pn * 256 + 32 * wc + 4 * fq) * 4u; asm volatile("" : "+v"(o)); return o; }
#define TILE_OFF(o0, ai, m, bj, n) ((o0) + (unsigned)(((ai) * 128 + (m) * 16) * DM * 4 + (128 * (bj) + 16 * (n)) * 4))
struct EpiOutLN {
    static constexpr bool PERM = false;
    const float* xp; float* Y; bf16_t* XB; LAS unsigned char* lx; float* rowstat; unsigned* cnt; const float* gam; const float* bet;
    __device__ __forceinline__ void operator()(f32x4 (&acc)[2][2][4][2], const Unit& u, int wr, int wc, int fr, int fq) const {
        { const unsigned o0 = tile_off0(u, wr, wc, fr, fq); const char* xb = (const char*)xp;
#pragma unroll
          for (int ai = 0; ai < 2; ++ai)
#pragma unroll
            for (int m = 0; m < 4; ++m) {
#pragma unroll
                for (int bj = 0; bj < 2; ++bj)
#pragma unroll
                    for (int n = 0; n < 2; ++n) acc[ai][bj][m][n] = __builtin_nontemporal_load((const f32x4*)(xb + TILE_OFF(o0, ai, m, bj, n))) * ALPHA + acc[ai][bj][m][n];
                if (m == 3) asm volatile("" : "+v"(acc[ai][0][0][0]), "+v"(acc[ai][0][0][1]), "+v"(acc[ai][1][0][0]), "+v"(acc[ai][1][0][1]), "+v"(acc[ai][0][1][0]), "+v"(acc[ai][0][1][1]), "+v"(acc[ai][1][1][0]), "+v"(acc[ai][1][1][1]),
                                               "+v"(acc[ai][0][2][0]), "+v"(acc[ai][0][2][1]), "+v"(acc[ai][1][2][0]), "+v"(acc[ai][1][2][1]), "+v"(acc[ai][0][3][0]), "+v"(acc[ai][0][3][1]), "+v"(acc[ai][1][3][0]), "+v"(acc[ai][1][3][1]) :: "memory"); } }
        ln_tile(acc, u, wr, wc, fr, fq, lx, rowstat, cnt + 64 * u.pm, 8u, gam, bet);
        { const unsigned o0 = tile_off0(u, wr, wc, fr, fq); char* yb = (char*)Y; char* bb = (char*)XB;
#pragma unroll
          for (int ai = 0; ai < 2; ++ai)
#pragma unroll
            for (int m = 0; m < 4; ++m) {
#pragma unroll
                for (int bj = 0; bj < 2; ++bj)
#pragma unroll
                    for (int n = 0; n < 2; ++n) { const unsigned o = TILE_OFF(o0, ai, m, bj, n); const f32x4 v = acc[ai][bj][m][n];
                        *(f32x4*)(yb + o) = v; u32x2 w; w.x = cvtpk(v[0], v[1]); w.y = cvtpk(v[2], v[3]); *(u32x2*)(bb + (o >> 1)) = w; }
                asm volatile("" ::: "memory"); } }
    }
};
struct EpiDownLN {
    static constexpr bool PERM = false;
    float* Y; LAS unsigned char* lx; float* rowstat; unsigned* cnt; const float* gam; const float* bet;
    __device__ __forceinline__ void operator()(f32x4 (&acc)[2][2][4][2], const Unit& u, int wr, int wc, int fr, int fq) const {
        { const unsigned o0 = tile_off0(u, wr, wc, fr, fq); const char* xb = (const char*)Y;
#pragma unroll
          for (int ai = 0; ai < 2; ++ai)
#pragma unroll
            for (int m = 0; m < 4; ++m) {
#pragma unroll
                for (int bj = 0; bj < 2; ++bj)
#pragma unroll
                    for (int n = 0; n < 2; ++n) acc[ai][bj][m][n] = __builtin_nontemporal_load((const f32x4*)(xb + TILE_OFF(o0, ai, m, bj, n))) * ALPHA + acc[ai][bj][m][n];
                if (m == 3) asm volatile("" : "+v"(acc[ai][0][0][0]), "+v"(acc[ai][0][0][1]), "+v"(acc[ai][1][0][0]), "+v"(acc[ai][1][0][1]), "+v"(acc[ai][0][1][0]), "+v"(acc[ai][0][1][1]), "+v"(acc[ai][1][1][0]), "+v"(acc[ai][1][1][1]),
                                               "+v"(acc[ai][0][2][0]), "+v"(acc[ai][0][2][1]), "+v"(acc[ai][1][2][0]), "+v"(acc[ai][1][2][1]), "+v"(acc[ai][0][3][0]), "+v"(acc[ai][0][3][1]), "+v"(acc[ai][1][3][0]), "+v"(acc[ai][1][3][1]) :: "memory"); } }
        ln_tile(acc, u, wr, wc, fr, fq, lx, rowstat, cnt + 64 * u.pm, 8u, gam, bet);
        { const unsigned o0 = tile_off0(u, wr, wc, fr, fq); char* yb = (char*)Y;
#pragma unroll
          for (int ai = 0; ai < 2; ++ai)
#pragma unroll
            for (int m = 0; m < 4; ++m) {
#pragma unroll
                for (int bj = 0; bj < 2; ++bj)
#pragma unroll
                    for (int n = 0; n < 2; ++n) __builtin_nontemporal_store(acc[ai][bj][m][n], (f32x4*)(yb + TILE_OFF(o0, ai, m, bj, n)));
                asm volatile("" ::: "memory"); } }
    }
};
__device__ __forceinline__ f32x2 ln_thin(f32x2 h, int r, int tid, float* rowstat, unsigned* cnt) {
    float s = h[0] + h[1], q = h[0] * h[0] + h[1] * h[1];
#pragma unroll
    for (int o = 1; o < 16; o <<= 1) { s += __shfl_xor(s, o); q += __shfl_xor(q, o); }
    if ((tid & 15) == 0) { (void)__hip_atomic_fetch_add(rowstat + (size_t)(r - SEQ) * 32, s, __ATOMIC_RELAXED, __HIP_MEMORY_SCOPE_AGENT); (void)__hip_atomic_fetch_add(rowstat + (size_t)(r - SEQ) * 32 + 1, q, __ATOMIC_RELAXED, __HIP_MEMORY_SCOPE_AGENT); }
    asm volatile("s_waitcnt vmcnt(0)" ::: "memory");
    __syncthreads();
    if (tid == 0) { (void)__hip_atomic_fetch_add(cnt, 1u, __ATOMIC_RELAXED, __HIP_MEMORY_SCOPE_AGENT);
        unsigned sp = 0; while (__hip_atomic_load(cnt, __ATOMIC_RELAXED, __HIP_MEMORY_SCOPE_AGENT) < 64u) { __builtin_amdgcn_s_sleep(1); if (++sp > (1u << 22)) break; }
        asm volatile("s_waitcnt vmcnt(0)" ::: "memory"); }
    __syncthreads();
    const float sm = __hip_atomic_load(rowstat + (size_t)(r - SEQ) * 32, __ATOMIC_RELAXED, __HIP_MEMORY_SCOPE_AGENT), sq = __hip_atomic_load(rowstat + (size_t)(r - SEQ) * 32 + 1, __ATOMIC_RELAXED, __HIP_MEMORY_SCOPE_AGENT);
    const float mean = sm * (1.f / DM), var = sq * (1.f / DM) - mean * mean, rstd = 1.f / sqrtf(fmaxf(var, 0.f) + LN_EPS);
    return (h - mean) * rstd;
}
struct EpiGU {
    static constexpr bool PERM = true;
    bf16_t* GU; float* out;
    __device__ __forceinline__ void operator()(const f32x4 (&acc)[2][2][4][2], const Unit& u, int wr, int wc, int fr, int fq) const {
#pragma unroll
        for (int ai = 0; ai < 2; ++ai)
#pragma unroll
            for (int m = 0; m < 4; ++m) { const int r = ROW_OF(u, ai, wr, m, fr);
                float* o = nullptr;
                if (u.pn < 22) { if (r >= SEQ - 2 && r < SEQ) o = out + O_CP + (size_t)(r - (SEQ - 2)) * FF; else if (r >= SEQ && r < MR) o = out + O_CS + ((size_t)(r - SEQ) * 2 + 1) * FF; }
#pragma unroll
                for (int bj = 0; bj < 2; ++bj) { const int c = u.pn * 256 + 128 * bj + 32 * wc + 8 * fq; const f32x4 v0 = acc[ai][bj][m][0], v1 = acc[ai][bj][m][1];
                    u32x4 w; w.x = cvtpk(v0[0], v0[1]); w.y = cvtpk(v0[2], v0[3]); w.z = cvtpk(v1[0], v1[1]); w.w = cvtpk(v1[2], v1[3]);
                    *(u32x4*)((u.pn < 22 ? GU + (size_t)r * FF + c : GU + (size_t)MP * FF + (size_t)r * FF + (c - FF))) = w;
                    if (o) { *(f32x4*)(o + c) = v0; *(f32x4*)(o + c + 4) = v1; } } }
    }
};
struct EpiDown {
    static constexpr bool PERM = false;
    float* Y;
    __device__ __forceinline__ void operator()(const f32x4 (&acc)[2][2][4][2], const Unit& u, int wr, int wc, int fr, int fq) const {
#pragma unroll
        for (int ai = 0; ai < 2; ++ai)
#pragma unroll
            for (int m = 0; m < 4; ++m) { const int r = ROW_OF(u, ai, wr, m, fr); if (r < MR) {
#pragma unroll
                for (int bj = 0; bj < 2; ++bj)
#pragma unroll
                    for (int n = 0; n < 2; ++n) { const int c = u.pn * 256 + 128 * bj + 32 * wc + 16 * n + 4 * fq; float* p = Y + (size_t)r * DM + c;
                        *(f32x4*)p = *(const f32x4*)p * ALPHA + acc[ai][bj][m][n]; } } }
    }
};

__device__ __forceinline__ int map_in_row(int c) {
    if (c >= 2304) return c;
    const int t = c & ~255, l = c & 255; return t + 128 * ((l >> 5) & 1) + 32 * (l >> 6) + (l & 31);
}
template <bool MAPIN>
__device__ __forceinline__ void transpose_item(const float* W, int N, bf16_t* WT, int K, int row_off, int k0, int n0, LAS float* scr, int lane) {
    const int kr = lane >> 4, nc = (lane & 15) * 4;
    f32x4 v[16];
#pragma unroll
    for (int i = 0; i < 16; ++i) v[i] = *(const f32x4*)(W + (size_t)(k0 + 4 * i + kr) * N + n0 + nc);
#pragma unroll
    for (int i = 0; i < 16; ++i) { LAS float* s = scr + (4 * i + kr) * 65 + nc; s[0] = v[i][0]; s[1] = v[i][1]; s[2] = v[i][2]; s[3] = v[i][3]; }
    asm volatile("s_waitcnt lgkmcnt(0)" ::: "memory");
    const int c = lane & 7;
#pragma unroll
    for (int j = 0; j < 8; ++j) { const int n = (lane >> 3) + 8 * j; const LAS float* s = scr + (8 * c) * 65 + n;
        u32x4 o; o.x = cvtpk(s[0], s[65]); o.y = cvtpk(s[2 * 65], s[3 * 65]); o.z = cvtpk(s[4 * 65], s[5 * 65]); o.w = cvtpk(s[6 * 65], s[7 * 65]);
        const int orow = MAPIN ? map_in_row(n0 + n) : (n0 + n);
        *(u32x4*)(WT + (size_t)(row_off + orow) * K + k0 + 8 * c) = o; }
    asm volatile("s_waitcnt lgkmcnt(0)" ::: "memory");
}

struct ConvPtrs { const float *w_in, *w_mix, *w_ab, *w_pb, *w_out, *w_gate, *w_up, *w_down; bf16_t *WinT, *WmixT, *WabT, *WpbT, *WoT, *WguT, *WdT; };
constexpr int CI_IN = 32 * 120, CI_MX = 4 * 16, CI_AB = 32 * 32, CI_PB = 16 * 32, CI_O = 32 * 32, CI_G = 32 * 88, CI_UP = 32 * 88, CI_D = 88 * 32;
constexpr int CI_EARLY = CI_IN + CI_PB, CI_ALL = CI_EARLY + CI_AB + CI_O + CI_G + CI_UP + CI_D;
__device__ __forceinline__ void convert_range(const ConvPtrs& P, int lo, int hi, int gw, int NGW, LAS float* scr, int lane) {
#define T_DECODE(IT, W_, N_, WT_, K_, RO_, K0_, N0_, MI_) do { int r_ = (IT); MI_ = 0; \
        if (r_ < CI_IN) { W_ = P.w_in; N_ = IND; WT_ = P.WinT; K_ = DM; RO_ = 0; K0_ = 64 * (r_ / 120); N0_ = 64 * (r_ % 120); MI_ = 1; break; } r_ -= CI_IN; \
        if (r_ < CI_PB) { W_ = P.w_pb; N_ = DM; WT_ = P.WpbT; K_ = PW; RO_ = 0; K0_ = 64 * (r_ / 32); N0_ = 64 * (r_ % 32); break; } r_ -= CI_PB; \
        if (r_ < CI_AB) { W_ = P.w_ab; N_ = DM; WT_ = P.WabT; K_ = DM; RO_ = 0; K0_ = 64 * (r_ / 32); N0_ = 64 * (r_ % 32); break; } r_ -= CI_AB; \
        if (r_ < CI_O) { W_ = P.w_out; N_ = DM; WT_ = P.WoT; K_ = DM; RO_ = 0; K0_ = 64 * (r_ / 32); N0_ = 64 * (r_ % 32); break; } r_ -= CI_O; \
        if (r_ < CI_G) { W_ = P.w_gate; N_ = FF; WT_ = P.WguT; K_ = DM; RO_ = 0; K0_ = 64 * (r_ / 88); N0_ = 64 * (r_ % 88); break; } r_ -= CI_G; \
        if (r_ < CI_UP) { W_ = P.w_up; N_ = FF; WT_ = P.WguT; K_ = DM; RO_ = FF; K0_ = 64 * (r_ / 88); N0_ = 64 * (r_ % 88); break; } r_ -= CI_UP; \
        { W_ = P.w_down; N_ = DM; WT_ = P.WdT; K_ = FF; RO_ = 0; K0_ = 64 * (r_ / 32); N0_ = 64 * (r_ % 32); } } while (0)
    const int kr = lane >> 4, nc = (lane & 15) * 4, cc = lane & 7;
    f32x4 va[16], vb[16];
    struct Desc { const float* W; bf16_t* WT; int N, K, RO, K0, N0, MI; };
    Desc da = {nullptr, nullptr, 0, 0, 0, 0, 0, 0}, db = da;
    int ita = lo + gw, itb = ita + NGW;
#define T_LOAD(V, D) do { _Pragma("unroll") for (int i = 0; i < 16; ++i) V[i] = __builtin_nontemporal_load((const f32x4*)(D.W + (size_t)(D.K0 + 4 * i + kr) * D.N + D.N0 + nc)); } while (0)
#define T_TOLDS(V) do { _Pragma("unroll") for (int i = 0; i < 16; ++i) { LAS float* sp = scr + (4 * i + kr) * 65 + nc; sp[0] = V[i][0]; sp[1] = V[i][1]; sp[2] = V[i][2]; sp[3] = V[i][3]; } } while (0)
#define T_FINISH(D) do { asm volatile("s_waitcnt lgkmcnt(0)" ::: "memory"); \
        _Pragma("unroll") for (int j = 0; j < 8; ++j) { const int n = (lane >> 3) + 8 * j; const LAS float* sp = scr + (8 * cc) * 65 + n; \
            u32x4 o; o.x = cvtpk(sp[0], sp[65]); o.y = cvtpk(sp[2 * 65], sp[3 * 65]); o.z = cvtpk(sp[4 * 65], sp[5 * 65]); o.w = cvtpk(sp[6 * 65], sp[7 * 65]); \
            const int orow = D.MI ? map_in_row(D.N0 + n) : (D.N0 + n); \
            *(u32x4*)(D.WT + (size_t)(D.RO + orow) * D.K + D.K0 + 8 * cc) = o; } \
        asm volatile("s_waitcnt lgkmcnt(0)" ::: "memory"); } while (0)
    if (ita < hi) { T_DECODE(ita, da.W, da.N, da.WT, da.K, da.RO, da.K0, da.N0, da.MI); T_LOAD(va, da); }
    if (itb < hi) { T_DECODE(itb, db.W, db.N, db.WT, db.K, db.RO, db.K0, db.N0, db.MI); T_LOAD(vb, db); }
    while (ita < hi) {
        { T_TOLDS(va); const Desc cur = da; ita += 2 * NGW;
          if (ita < hi) { T_DECODE(ita, da.W, da.N, da.WT, da.K, da.RO, da.K0, da.N0, da.MI); T_LOAD(va, da); }
          T_FINISH(cur); }
        if (itb < hi) { T_TOLDS(vb); const Desc cur = db; itb += 2 * NGW;
          if (itb < hi) { T_DECODE(itb, db.W, db.N, db.WT, db.K, db.RO, db.K0, db.N0, db.MI); T_LOAD(vb, db); }
          T_FINISH(cur); }
    }
#undef T_LOAD
#undef T_TOLDS
#undef T_FINISH
#undef T_DECODE
}

__device__ __forceinline__ float wave_sum(float v) {
#pragma unroll
    for (int o = 1; o < 64; o <<= 1) v += __shfl_xor(v, o);
    return v;
}
__device__ __forceinline__ float wave_max(float v) {
#pragma unroll
    for (int o = 1; o < 64; o <<= 1) v = fmaxf(v, __shfl_xor(v, o));
    return v;
}
__device__ __forceinline__ void ln_row(const float* src, const float* gam, const float* bet, float* dstF, bf16_t* dstB, int lane) {
    f32x4 v[8]; float s = 0.f;
#pragma unroll
    for (int j = 0; j < 8; ++j) { v[j] = *(const f32x4*)(src + 4 * lane + 256 * j); s += (v[j][0] + v[j][1]) + (v[j][2] + v[j][3]); }
    const float mean = wave_sum(s) * (1.f / DM); float q = 0.f;
#pragma unroll
    for (int j = 0; j < 8; ++j) { v[j] = v[j] - mean; q += (v[j][0] * v[j][0] + v[j][1] * v[j][1]) + (v[j][2] * v[j][2] + v[j][3] * v[j][3]); }
    const float rstd = 1.f / sqrtf(wave_sum(q) * (1.f / DM) + LN_EPS);
#pragma unroll
    for (int j = 0; j < 8; ++j) { const f32x4 g = *(const f32x4*)(gam + 4 * lane + 256 * j), b = *(const f32x4*)(bet + 4 * lane + 256 * j); const f32x4 o = v[j] * rstd * g + b;
        *(f32x4*)(dstF + 4 * lane + 256 * j) = o;
        if (dstB) { u32x2 w; w.x = cvtpk(o[0], o[1]); w.y = cvtpk(o[2], o[3]); *(u32x2*)(dstB + 4 * lane + 256 * j) = w; } }
}

__device__ __forceinline__ int crow(int r, int hi) { return (r & 3) + 8 * (r >> 2) + 4 * hi; }
__device__ __forceinline__ void attn_prompt_unit(LAS unsigned char* lds, int tid, int kvh, int qb, const bf16_t* Q, const bf16_t* Kb, const bf16_t* Vb, bf16_t* AO, const float* sinks) {
    const int lane = tid & 63, w = tid >> 6, q = lane & 31, hi = lane >> 5;
    const int q0 = qb * 32, kb0 = q0 - 128, head = kvh * 8 + w;
    LAS unsigned char* Ks = lds; LAS unsigned char* Vt = lds + 23040;
    bf16x8 qf[4]; const bf16_t* qp = Q + (size_t)(q0 + q) * DM + head * 64 + hi * 8;
#pragma unroll
    for (int dc = 0; dc < 4; ++dc) qf[dc] = *(const bf16x8*)(qp + 16 * dc);
    for (int it = tid; it < 1280; it += 512) {
        const int row = it >> 3, ch = it & 7, kp = kb0 + row;
        u32x4 kv = {0u, 0u, 0u, 0u}, vv = {0u, 0u, 0u, 0u};
        if (kp >= 0) { kv = *(const u32x4*)(Kb + (size_t)kp * KVD + kvh * 64 + ch * 8); vv = *(const u32x4*)(Vb + (size_t)kp * KVD + kvh * 64 + ch * 8); }
        *(LAS u32x4*)(Ks + row * 144 + ch * 16) = kv;
#pragma unroll
        for (int e = 0; e < 8; ++e) { const unsigned wv = vv[e >> 1]; *(LAS unsigned short*)(Vt + (8 * ch + e) * 328 + row * 2) = (unsigned short)((e & 1) ? (wv >> 16) : (wv & 0xffffu)); }
    }
    __syncthreads();
    f32x16 p[5];
#pragma unroll
    for (int j = 0; j < 5; ++j) {
        p[j] = (f32x16){0.f, 0.f, 0.f, 0.f, 0.f, 0.f, 0.f, 0.f, 0.f, 0.f, 0.f, 0.f, 0.f, 0.f, 0.f, 0.f};
#pragma unroll
        for (int dc = 0; dc < 4; ++dc) { const bf16x8 kf = *(const LAS bf16x8*)(Ks + (32 * j + q) * 144 + (16 * dc + 8 * hi) * 2); p[j] = __builtin_amdgcn_mfma_f32_32x32x16_bf16(kf, qf[dc], p[j], 0, 0, 0); }
    }
    const int qpos = q0 + q; float mx = -1e30f;
#pragma unroll
    for (int j = 0; j < 5; ++j)
#pragma unroll
        for (int r = 0; r < 16; ++r) { const int kp = kb0 + 32 * j + crow(r, hi); const bool vis = (kp >= 0) && (kp <= qpos) && (kp > qpos - 128);
            const float s = vis ? p[j][r] : -1e30f; p[j][r] = s; mx = fmaxf(mx, s); }
    mx = fmaxf(mx, __shfl_xor(mx, 32)); const float sk = sinks[head] * LOG2E; mx = fmaxf(mx, sk);
    float l = 0.f;
#pragma unroll
    for (int j = 0; j < 5; ++j)
#pragma unroll
        for (int r = 0; r < 16; ++r) { const float e = __builtin_amdgcn_exp2f(p[j][r] - mx); p[j][r] = e; l += e; }
    l += __shfl_xor(l, 32); const float inv = 1.f / (l + __builtin_amdgcn_exp2f(sk - mx));
    f32x16 o[2];
    o[0] = (f32x16){0.f, 0.f, 0.f, 0.f, 0.f, 0.f, 0.f, 0.f, 0.f, 0.f, 0.f, 0.f, 0.f, 0.f, 0.f, 0.f}; o[1] = o[0];
#pragma unroll
    for (int c = 0; c < 10; ++c) { const int j = c >> 1, h8 = (c & 1) * 8;
        u32x4 pw; pw.x = cvtpk(p[j][h8 + 0], p[j][h8 + 1]); pw.y = cvtpk(p[j][h8 + 2], p[j][h8 + 3]); pw.z = cvtpk(p[j][h8 + 4], p[j][h8 + 5]); pw.w = cvtpk(p[j][h8 + 6], p[j][h8 + 7]);
        const bf16x8 pa = __builtin_bit_cast(bf16x8, pw);
#pragma unroll
        for (int dh = 0; dh < 2; ++dh) { const LAS unsigned char* vp = Vt + (32 * dh + q) * 328 + (16 * c + 4 * hi) * 2;
            const u32x2 lo = *(const LAS u32x2*)vp, hh = *(const LAS u32x2*)(vp + 16); u32x4 vw; vw.x = lo.x; vw.y = lo.y; vw.z = hh.x; vw.w = hh.y;
            o[dh] = __builtin_amdgcn_mfma_f32_32x32x16_bf16(__builtin_bit_cast(bf16x8, vw), pa, o[dh], 0, 0, 0); } }
    bf16_t* op = AO + (size_t)(q0 + q) * DM + head * 64;
#pragma unroll
    for (int dh = 0; dh < 2; ++dh)
#pragma unroll
        for (int g4 = 0; g4 < 4; ++g4) { u32x2 wv; wv.x = cvtpk(o[dh][4 * g4] * inv, o[dh][4 * g4 + 1] * inv); wv.y = cvtpk(o[dh][4 * g4 + 2] * inv, o[dh][4 * g4 + 3] * inv);
            *(u32x2*)(op + 32 * dh + 8 * g4 + 4 * hi) = wv; }
    __syncthreads();
}
__device__ __forceinline__ void attn_sample_unit(LAS unsigned char* lds, int tid, int b, int kvh, const bf16_t* Q, const float* KS, const float* VS, bf16_t* AO, const float* sinks) {
    const int lane = tid & 63, w = tid >> 6;
    LAS float* Ksf = (LAS float*)lds; LAS float* Vsf = (LAS float*)(lds + 33280); LAS float* Qs = (LAS float*)(lds + 66048); LAS float* Ss = (LAS float*)(lds + 68096); LAS float* den = (LAS float*)(lds + 72192);
    for (int it = tid; it < 2048; it += 512) { const int key = it >> 4, ch = it & 15; const size_t off = ((size_t)(b * 128 + key)) * 256 + kvh * 64 + 4 * ch;
        const f32x4 kv = *(const f32x4*)(KS + off), vv = *(const f32x4*)(VS + off);
        LAS float* kd = Ksf + key * 65 + 4 * ch; kd[0] = kv[0]; kd[1] = kv[1]; kd[2] = kv[2]; kd[3] = kv[3];
        *(LAS f32x4*)(Vsf + key * 64 + 4 * ch) = vv; }
    { const int h = tid >> 6, d = tid & 63; Qs[h * 64 + d] = bf2f(Q[(size_t)(SEQ + b) * DM + (kvh * 8 + h) * 64 + d]); }
    __syncthreads();
    { const int key = tid & 127, hg = tid >> 7;
#pragma unroll
      for (int hh = 0; hh < 2; ++hh) { const int h = 2 * hg + hh; float s = 0.f;
#pragma unroll 16
          for (int d = 0; d < 64; ++d) s += Qs[h * 64 + d] * Ksf[key * 65 + d];
          Ss[h * 128 + key] = s; } }
    __syncthreads();
    { const int h = w; const float s0 = Ss[h * 128 + lane], s1 = Ss[h * 128 + 64 + lane]; const float sk = sinks[kvh * 8 + h] * LOG2E;
      const float m = fmaxf(wave_max(fmaxf(s0, s1)), sk); const float e0 = __builtin_amdgcn_exp2f(s0 - m), e1 = __builtin_amdgcn_exp2f(s1 - m);
      const float l = wave_sum(e0 + e1); Ss[h * 128 + lane] = e0; Ss[h * 128 + 64 + lane] = e1; if (lane == 0) den[h] = l + __builtin_amdgcn_exp2f(sk - m); }
    __syncthreads();
    { const int h = tid >> 6, d = tid & 63; float o = 0.f;
#pragma unroll 16
      for (int key = 0; key < 128; ++key) o += Ss[h * 128 + key] * Vsf[key * 64 + d];
      o = o / den[h];
      const unsigned pk = cvtpk(o, 0.f); AO[(size_t)(SEQ + b) * DM + (kvh * 8 + h) * 64 + d] = (bf16_t)(pk & 0xffffu); }
    __syncthreads();
}


__device__ __forceinline__ f32x2 thin_unit(LAS unsigned char* lds, int wave, int lane, const bf16_t* A, int lda, const bf16_t* Bt, int ldb, int K) {
    const int fr = lane & 15, fq = lane >> 4, kw = K >> 3;
    const bf16_t* ap = A + (size_t)fr * lda + wave * kw + 8 * fq;
    const bf16_t* bp = Bt + (size_t)fr * ldb + wave * kw + 8 * fq;
    const size_t a16 = (size_t)16 * lda, b16 = (size_t)16 * ldb;
    f32x4 acc[2][2];
#pragma unroll
    for (int i = 0; i < 2; ++i)
#pragma unroll
        for (int j = 0; j < 2; ++j) acc[i][j] = (f32x4){0.f, 0.f, 0.f, 0.f};
#pragma unroll 4
    for (int k = 0; k < kw; k += 64) {
        bf16x8 af[2][2], bfr[2][2];
#pragma unroll
        for (int i = 0; i < 2; ++i)
#pragma unroll
            for (int st = 0; st < 2; ++st) { af[i][st] = *(const bf16x8*)(ap + i * a16 + k + 32 * st); bfr[i][st] = *(const bf16x8*)(bp + i * b16 + k + 32 * st); }
#pragma unroll
        for (int st = 0; st < 2; ++st)
#pragma unroll
            for (int i = 0; i < 2; ++i)
#pragma unroll
                for (int j = 0; j < 2; ++j) acc[i][j] = __builtin_amdgcn_mfma_f32_16x16x32_bf16(af[i][st], bfr[j][st], acc[i][j], 0, 0, 0);
    }
    LAS float* part = (LAS float*)lds;
#pragma unroll
    for (int i = 0; i < 2; ++i)
#pragma unroll
        for (int j = 0; j < 2; ++j)
#pragma unroll
            for (int q = 0; q < 4; ++q) part[wave * 1024 + (16 * i + 4 * fq + q) * 32 + 16 * j + fr] = acc[i][j][q];
    __syncthreads();
    const int t = wave * 64 + lane; f32x2 o = {0.f, 0.f};
#pragma unroll
    for (int w = 0; w < 8; ++w) { const f32x2 v = *(const LAS f32x2*)(part + w * 1024 + (t >> 4) * 32 + 2 * (t & 15)); o += v; }
    __syncthreads();
    return o;
}

template <int W>
__device__ __forceinline__ void pool_item(const float* U, bf16_t* DP, int r0, int c) {
    f32x4 v[16 + W - 1];
#pragma unroll
    for (int i = 0; i < 16 + W - 1; ++i) { const int r = r0 - (W - 1) + i; v[i] = r >= 0 ? *(const f32x4*)(U + (size_t)r * PW + c) : (f32x4){0.f, 0.f, 0.f, 0.f}; }
    f32x4 tot = {0.f, 0.f, 0.f, 0.f};
#pragma unroll
    for (int i = 0; i < W - 1; ++i) tot += v[i];
#pragma unroll
    for (int i = 0; i < 16; ++i) { const int r = r0 + i; tot += v[W - 1 + i]; const float rc = 1.f / (float)(r + 1 < W ? r + 1 : W); const f32x4 d = tot * rc - v[W - 1 + i];
        u32x2 w; w.x = cvtpk(d[0], d[1]); w.y = cvtpk(d[2], d[3]); *(u32x2*)(DP + (size_t)r * DM + c) = w; tot -= v[i]; }
}

__device__ __forceinline__ float gelu_tanh(float x) {
    const float z = 0.7978845608028654f * (x + 0.044715f * x * x * x);
    const float t = __builtin_amdgcn_exp2f(2.885390081777927f * z);
    const float th = 1.f - 2.f * __builtin_amdgcn_rcpf(t + 1.f);
    return 0.5f * x * (1.f + th);
}


#define XB_TMO      128
#define XB_XCNT(j)  (256  + 64 * (j))
#define XB_XSUB(j)  (1280 + 64 * (j))
#define XB_XGEN(j)  (2304 + 64 * (j))
#define XB_TOP      3328
#define XB_TOPGEN   3392
#define XCD_BAR_WORDS 3456
#define XB_SPIN_CAP (1u << 18)
__device__ __forceinline__ unsigned xb_ld(unsigned* p)              { return __hip_atomic_load(p, __ATOMIC_RELAXED, __HIP_MEMORY_SCOPE_AGENT); }
__device__ __forceinline__ unsigned xb_add(unsigned* p, unsigned v) { return __hip_atomic_fetch_add(p, v, __ATOMIC_RELAXED, __HIP_MEMORY_SCOPE_AGENT); }
__device__ __forceinline__ unsigned xb_xcc_id() { return (unsigned)__builtin_amdgcn_s_getreg((3 << 11) | 20) & 0xFu; }
#define XB_SPIN(cond, bar) do { unsigned _sp = 0; while (cond) { __builtin_amdgcn_s_sleep(1); \
    if ((++_sp & 255u) == 0u) { if (xb_ld(&(bar)[XB_TMO])) break; if (_sp > XB_SPIN_CAP) { atomicAdd(&(bar)[XB_TMO], 1u); break; } } } } while (0)
struct XcdBarrier { unsigned* bar; unsigned x; volatile LAS unsigned* st; };
__device__ __forceinline__ void xcd_barrier_complete(unsigned* bar, unsigned x, unsigned& nloc, unsigned& nx) {
    const unsigned G = gridDim.x * gridDim.y * gridDim.z;
    unsigned sum, cnt, mine, sp = 0u;
    for (;;) {
        sum = 0u; cnt = 0u; mine = 0u;
#pragma unroll
        for (unsigned j = 0; j < 16; ++j) { const unsigned c = xb_ld(&bar[XB_XCNT(j)]); sum += c; cnt += (c > 0u) ? 1u : 0u; mine = (j == x) ? c : mine; }
        if (sum == G) break;
        __builtin_amdgcn_s_sleep(1);
        if ((++sp & 255u) == 0u) { if (xb_ld(&bar[XB_TMO])) break; if (sp > XB_SPIN_CAP) { atomicAdd(&bar[XB_TMO], 1u); break; } }
    }
    nloc = mine > 0u ? mine : 1u; nx = cnt > 0u ? cnt : 1u;
}
__device__ __forceinline__ void xcd_barrier(const XcdBarrier& b, bool t0) {
    asm volatile("s_waitcnt vmcnt(0)" ::: "memory");
    __syncthreads();
    if (t0) {
        unsigned* bar = b.bar;
        __builtin_amdgcn_s_waitcnt(0);
        unsigned nloc = b.st[0], nx = b.st[1];
        if (nloc == 0u) { xcd_barrier_complete(bar, b.x, nloc, nx); b.st[0] = nloc; b.st[1] = nx; }
        const unsigned old = xb_add(&bar[XB_XSUB(b.x)], 1u);
        const unsigned gen = old / nloc;
        if (old + 1u == (gen + 1u) * nloc) {
            __builtin_amdgcn_fence(__ATOMIC_RELEASE, "agent");
            asm volatile("s_waitcnt vmcnt(0)" ::: "memory");
            const unsigned og = xb_add(&bar[XB_TOP], 1u);
            const unsigned tg = og / nx;
            if (og + 1u == (tg + 1u) * nx) xb_add(&bar[XB_TOPGEN], 1u);
            else XB_SPIN(xb_ld(&bar[XB_TOPGEN]) == tg, bar);
            __builtin_amdgcn_fence(__ATOMIC_ACQUIRE, "agent");
            xb_add(&bar[XB_XGEN(b.x)], 1u);
            asm volatile("s_waitcnt vmcnt(0)" ::: "memory");
        } else {
            XB_SPIN(xb_ld(&bar[XB_XGEN(b.x)]) == gen, bar);
            __builtin_amdgcn_fence(__ATOMIC_ACQUIRE, "agent");
            asm volatile("s_waitcnt vmcnt(0)" ::: "memory");
        }
    }
    __syncthreads();
}

struct Args { const float* in[22]; float* out; unsigned char* ws; };

__global__ void __launch_bounds__(512, 2) mega_fwd(Args a) {
    extern __shared__ __attribute__((aligned(16))) unsigned char lds_raw[];
    LAS unsigned char* lds = (LAS unsigned char*)lds_raw;
    cg::grid_group grid = cg::this_grid();
    const int wave = __builtin_amdgcn_readfirstlane(threadIdx.x >> 6), G = gridDim.x, bx = blockIdx.x;
    const int gw = bx * 8 + wave, NGW = G * 8;
    const size_t NGT = (size_t)G * 512;
    volatile LAS unsigned* MISC = (volatile LAS unsigned*)(lds + LDS_BYTES - 64);
    if (threadIdx.x < 16) MISC[threadIdx.x] = 0u;
    __syncthreads();
    XcdBarrier xbar; xbar.bar = (unsigned*)(a.ws + WS_CTL); xbar.x = xb_xcc_id(); xbar.st = MISC;
    if (threadIdx.x == 0) (void)xb_add(&xbar.bar[XB_XCNT(xbar.x)], 1u);
    if (G == 0x7fffffff) grid.sync();
#define GRID_SYNC() xcd_barrier(xbar, wave == 0 && lane_fresh() == 0)
#define FRESH_IDS const int lane = lane_fresh(); const int tid = wave * 64 + lane; const size_t gt = (size_t)bx * 512 + tid; (void)gt; (void)tid;
    unsigned char* ws = a.ws; float* out = a.out;
    const float* x_p = a.in[0]; const float* x_s = a.in[1]; const float* cache_k = a.in[2]; const float* cache_v = a.in[3]; const float* st_pool = a.in[4]; const float* st_conv = a.in[5];
    const float* w_in = a.in[6]; const float* sinks = a.in[7]; const float* w_mix = a.in[8]; const float* pool_scale = a.in[9]; const float* w_ab = a.in[10]; const float* w_pb = a.in[11];
    const float* w_out = a.in[12]; const float* ln1g = a.in[13]; const float* ln1b = a.in[14]; const float* w_up = a.in[15]; const float* w_gate = a.in[16]; const float* conv_w = a.in[17];
    const float* conv_b = a.in[18]; const float* w_down = a.in[19]; const float* ln2g = a.in[20]; const float* ln2b = a.in[21];
    bf16_t* WguT = (bf16_t*)(ws + WS_WGU); bf16_t* WdT = (bf16_t*)(ws + WS_WD); bf16_t* R1 = (bf16_t*)(ws + WS_R1);
    bf16_t* WinT = (bf16_t*)(ws + WS_WIN); bf16_t* WabT = (bf16_t*)(ws + WS_WAB); bf16_t* WpbT = (bf16_t*)(ws + WS_WPB); bf16_t* WmixT = (bf16_t*)(ws + WS_WMIX); bf16_t* WoT = (bf16_t*)(ws + WS_WO);
    bf16_t* R2 = (bf16_t*)(ws + WS_R2); float* U = (float*)(ws + WS_U); unsigned short* SG = (unsigned short*)(ws + WS_SG); float* H1 = (float*)(ws + WS_SG);
    bf16_t* Kb = (bf16_t*)(ws + WS_KB); bf16_t* Vb = (bf16_t*)(ws + WS_VB); bf16_t* DP = (bf16_t*)(ws + WS_DP); bf16_t* PY = (bf16_t*)(ws + WS_PY);
    float* COS = (float*)(ws + WS_COS); float* SIN = (float*)(ws + WS_SIN); bf16_t* GU = (bf16_t*)(ws + WS_GU); bf16_t* UB = GU + (size_t)MP * FF;
    const ConvPtrs CP{w_in, w_mix, w_ab, w_pb, w_out, w_gate, w_up, w_down, WinT, WmixT, WabT, WpbT, WoT, WguT, WdT};
    float* Y = out + O_Y;

    {
        FRESH_IDS
        LAS float* scr = (LAS float*)(lds + wave * 16640);
        convert_range(CP, 0, CI_EARLY, gw, NGW, scr, lane);
        for (size_t i0 = gt; i0 < (size_t)MP * DM / 8; i0 += 4 * NGT) {
            f32x4 a0[4], a1[4];
#pragma unroll
            for (int u = 0; u < 4; ++u) { const size_t e = (i0 + u * NGT) * 8; const int r = (int)(e / DM), c = (int)(e % DM); a0[u] = (f32x4){0.f, 0.f, 0.f, 0.f}; a1[u] = a0[u];
                if (r < MR) { const float* src = r < SEQ ? x_p + (size_t)r * DM + c : x_s + (size_t)(r - SEQ) * DM + c; a0[u] = __builtin_nontemporal_load((const f32x4*)src); a1[u] = __builtin_nontemporal_load((const f32x4*)(src + 4)); } }
#pragma unroll
            for (int u = 0; u < 4; ++u) { const size_t e = (i0 + u * NGT) * 8; if (e < (size_t)MP * DM) { u32x4 w; w.x = cvtpk(a0[u][0], a0[u][1]); w.y = cvtpk(a0[u][2], a0[u][3]); w.z = cvtpk(a1[u][0], a1[u][1]); w.w = cvtpk(a1[u][2], a1[u][3]);
                *(u32x4*)(R1 + e) = w; } }
        }
        for (size_t i = gt; i < (size_t)4 * 256 * 256 / 8; i += NGT) { const size_t e = i * 8; const int g = (int)(e >> 16), d = (int)(e & 255);
            const f32x4 a0 = *(const f32x4*)(w_mix + e), a1 = *(const f32x4*)(w_mix + e + 4), s0 = *(const f32x4*)(pool_scale + 256 * g + d), s1 = *(const f32x4*)(pool_scale + 256 * g + d + 4);
            const f32x4 p0 = a0 * s0, p1 = a1 * s1; u32x4 w; w.x = cvtpk(p0[0], p0[1]); w.y = cvtpk(p0[2], p0[3]); w.z = cvtpk(p1[0], p1[1]); w.w = cvtpk(p1[2], p1[3]); *(u32x4*)(WmixT + e) = w; }
        for (size_t i = gt; i < (size_t)CTL_PAD_BYTES / 16; i += NGT) ((u32x4*)(ws + WS_CTL + CTL_BYTES))[i] = (u32x4){0u, 0u, 0u, 0u};
        for (size_t i = gt; i < (size_t)(SEQ + 1) * 32; i += NGT) { const int pos = (int)(i >> 5), j = (int)(i & 31);
            const double inv = exp2(-(double)j * (13.287712379549449 / 32.0)); const double ang = (double)pos * inv; COS[i] = (float)cos(ang); SIN[i] = (float)sin(ang); }
    }
    GRID_SYNC();

    {
        if ((bx & 1) == 0) { FRESH_IDS convert_range(CP, CI_EARLY, G == 256 ? CI_ALL - CI_D : CI_ALL, gw, NGW, (LAS float*)(lds + wave * 16640), lane);
        const size_t gt2 = (size_t)(bx >> 1) * 512 + tid, NGT2 = (size_t)((G + 1) >> 1) * 512; (void)gt2;
        for (size_t i0 = gt2; i0 < (size_t)NSMP * 127 * 64; i0 += 4 * NGT2) {
            f32x4 kk[4], vv[4];
#pragma unroll
            for (int u = 0; u < 4; ++u) { const size_t i = i0 + u * NGT2; if (i < (size_t)NSMP * 127 * 64) { const size_t b = i / (127 * 64), rem = i % (127 * 64); const size_t so = (b * 128 + 1) * 256 + rem * 4;
                kk[u] = __builtin_nontemporal_load((const f32x4*)(cache_k + so)); } }
#pragma unroll
            for (int u = 0; u < 4; ++u) { const size_t i = i0 + u * NGT2; if (i < (size_t)NSMP * 127 * 64) { const size_t b = i / (127 * 64), rem = i % (127 * 64); const size_t dof = b * 128 * 256 + rem * 4;
                *(f32x4*)(out + O_KS + dof) = kk[u]; } }
        }
        for (size_t i = gt2; i < (size_t)NSMP * 14 * 256; i += NGT2) { const size_t b = i / (14 * 256), rem = i % (14 * 256);
            *(f32x4*)(out + O_PS + b * 15 * PW + rem * 4) = *(const f32x4*)(st_pool + (b * 15 + 1) * PW + rem * 4); }
            __syncthreads(); }
        { pg8::Gemm g{R1, WinT, DM, DM, DM, 0}; pg8::StaticOrder S; S.init(MP, IND, G, bx);
          EpiIn E{R2, Kb, Vb, U, SG, COS, SIN, out};
          pg8::gemm_phase<EpiIn>(lds, g, S, E, wave); }
        { const int first = (G == 256) ? 222 : 0;
          if (bx >= first && bx < first + 32) { pg8::Gemm g{WpbT, WmixT, 256, PW, 256, 256}; pg8::StaticOrder S; S.init(DM, PW, 32, bx - first); EpiWeff E{PY}; pg8::gemm_phase<EpiWeff>(lds, g, S, E, wave); } }
        if ((bx & 1) != 0) { FRESH_IDS convert_range(CP, CI_EARLY, G == 256 ? CI_ALL - CI_D : CI_ALL, gw, NGW, (LAS float*)(lds + wave * 16640), lane);
        const size_t gt2 = (size_t)(bx >> 1) * 512 + tid, NGT2 = (size_t)((G + 1) >> 1) * 512; (void)gt2;
        for (size_t i0 = gt2; i0 < (size_t)NSMP * 127 * 64; i0 += 4 * NGT2) {
            f32x4 kk[4], vv[4];
#pragma unroll
            for (int u = 0; u < 4; ++u) { const size_t i = i0 + u * NGT2; if (i < (size_t)NSMP * 127 * 64) { const size_t b = i / (127 * 64), rem = i % (127 * 64); const size_t so = (b * 128 + 1) * 256 + rem * 4;
                 vv[u] = __builtin_nontemporal_load((const f32x4*)(cache_v + so)); } }
#pragma unroll
            for (int u = 0; u < 4; ++u) { const size_t i = i0 + u * NGT2; if (i < (size_t)NSMP * 127 * 64) { const size_t b = i / (127 * 64), rem = i % (127 * 64); const size_t dof = b * 128 * 256 + rem * 4;
                 *(f32x4*)(out + O_VS + dof) = vv[u]; } }
        }
        for (size_t i = gt2; i < (size_t)NSMP * (FF / 4); i += NGT2) { const size_t b = i / (FF / 4), rem = i % (FF / 4);
            *(f32x4*)(out + O_CS + b * 2 * FF + rem * 4) = *(const f32x4*)(st_conv + (b * 2 + 1) * FF + rem * 4); }
        }
    }
    GRID_SYNC();

    {
        FRESH_IDS
        bf16_t* AO = R1;
        for (int id = bx; id < 1024; id += G) attn_prompt_unit(lds, tid, id & 3, id >> 2, R2, Kb, Vb, AO, sinks);
        for (int id = bx; id < 512; id += G) attn_sample_unit(lds, tid, id >> 2, id & 3, R2, out + O_KS, out + O_VS, AO, sinks);
        const size_t NPI = (size_t)(SEQ / 16) * 256, NSI = (size_t)NSMP * 256;
        for (size_t it = gt; it < NPI + NSI; it += NGT) {
            if (it < NPI) {
                const int rb = (int)(it >> 8), c = (int)(it & 255) * 4, g = c >> 8, r0 = rb * 16;
                if (g == 0) pool_item<2>(U, DP, r0, c); else if (g == 1) pool_item<4>(U, DP, r0, c); else if (g == 2) pool_item<8>(U, DP, r0, c); else pool_item<16>(U, DP, r0, c);
            } else {
                const size_t k = it - NPI; const int b = (int)(k >> 8), c = (int)(k & 255) * 4, wdw = 2 << (c >> 8), r = SEQ + b;
                const f32x4 cur = *(const f32x4*)(U + (size_t)r * PW + c); f32x4 tot = cur;
                for (int j = 1; j < wdw; ++j) tot += *(const f32x4*)(st_pool + ((size_t)b * 15 + (15 - j)) * PW + c);
                const f32x4 d = tot * (1.f / (float)wdw) - cur;
                u32x2 w; w.x = cvtpk(d[0], d[1]); w.y = cvtpk(d[2], d[3]); *(u32x2*)(DP + (size_t)r * DM + c) = w;
            }
        }
    }
    GRID_SYNC();

    {
        { pg8::Gemm g0{DP, PY  , PW, DM, DM, 0}; pg8::Gemm g1{R1  , WabT, DM, DM, DM, 0}; pg8::StaticOrder S; S.init(SEQ, DM, G, bx); EpiBr E{SG, R2}; pg8::gemm_phase2<EpiBr>(lds, g0, g1, S, E, wave); }
        { FRESH_IDS
          for (int id = bx; id < 256; id += G) { const int r0 = SEQ + 32 * (id & 3), c0 = 32 * (id >> 2);
              const f32x2 va = thin_unit(lds, wave, lane, DP + (size_t)r0 * DM, DM, PY + (size_t)c0 * DM, DM, PW);
              const f32x2 vb = thin_unit(lds, wave, lane, R1 + (size_t)r0 * DM, DM, WabT + (size_t)c0 * DM, DM, DM);
              const int r = r0 + (tid >> 4), c = c0 + 2 * (tid & 15);
              const unsigned gp = *(const unsigned*)(SG + (size_t)r * 4096 + c), ga = *(const unsigned*)(SG + (size_t)r * 4096 + 2048 + c);
              *(unsigned*)(R2 + (size_t)r * DM + c) = cvtpk(hlo(gp) * va[0] + hlo(ga) * vb[0], hhi(gp) * va[1] + hhi(ga) * vb[1]); } }
    }
    GRID_SYNC();

    {
        unsigned* ctl = (unsigned*)(ws + WS_CTL); float* rs1 = (float*)(ctl + CW_PS1);
        if (G == 256) { pg8::Gemm g{R2, WoT, DM, DM, DM, 0}; pg8::StaticOrder S; S.init(SEQ, DM, G, bx); EpiOutLN E{x_p, Y, R1, lds + 131072, rs1, ctl + CW_CNT, ln1g, ln1b}; pg8::gemm_phase<EpiOutLN>(lds, g, S, E, wave); }
        { FRESH_IDS
          if (G == 256) { const int id = bx; const int r0 = SEQ + 32 * (id & 3), c0 = 32 * (id >> 2);
              const f32x2 v = thin_unit(lds, wave, lane, R2 + (size_t)r0 * DM, DM, WoT + (size_t)c0 * DM, DM, DM);
              const int r = r0 + (tid >> 4), c = c0 + 2 * (tid & 15);
              const f32x2 xv = *(const f32x2*)(x_s + (size_t)(r - SEQ) * DM + c);
              const f32x2 z = ln_thin(xv * ALPHA + v, r, tid, (float*)(ctl + CW_TS1), ctl + CW_CNT + 2048 + 64 * (id & 3));
              const f32x2 o = z * *(const f32x2*)(ln1g + c) + *(const f32x2*)(ln1b + c);
              *(f32x2*)(Y + (size_t)r * DM + c) = o; *(unsigned*)(R1 + (size_t)r * DM + c) = cvtpk(o[0], o[1]); } }
    }
    GRID_SYNC();

    {
        pg8::Gemm g{R1, WguT, DM, DM, DM, 0}; pg8::StaticOrder S; S.init(MP, 2 * FF, G, bx, 3); EpiGU E{GU, out}; pg8::gemm_phase<EpiGU>(lds, g, S, E, wave);
        if (G == 256 && bx >= 172) { FRESH_IDS convert_range(CP, CI_ALL - CI_D, CI_ALL, gw - 172 * 8, 84 * 8, (LAS float*)(lds + wave * 16640), lane); }
    }
    GRID_SYNC();

    { FRESH_IDS
      const size_t NPI = (size_t)(SEQ / 8) * (FF / 8), NSI = (size_t)NSMP * (FF / 8);
      for (size_t it = gt; it < NPI + NSI; it += NGT) {
          const bool smp = it >= NPI; const size_t k = smp ? it - NPI : it;
          const int rb = (int)(k / (FF / 8)), c = (int)(k % (FF / 8)) * 8;
          f32x4 cw[3][2], cb[2];
#pragma unroll
          for (int h = 0; h < 2; ++h) { cb[h] = *(const f32x4*)(conv_b + c + 4 * h);
#pragma unroll
              for (int j = 0; j < 3; ++j) cw[j][h] = *(const f32x4*)(conv_w + (size_t)j * FF + c + 4 * h); }
          if (!smp) {
              const int r0 = rb * 8; u32x4 gw_[10], uw[8];
#pragma unroll
              for (int i = 0; i < 10; ++i) { const int r = r0 - 2 + i; gw_[i] = r >= 0 ? *(const u32x4*)(GU + (size_t)r * FF + c) : (u32x4){0u, 0u, 0u, 0u}; }
#pragma unroll
              for (int i = 0; i < 8; ++i) uw[i] = *(const u32x4*)(UB + (size_t)(r0 + i) * FF + c);
#pragma unroll
              for (int i = 0; i < 8; ++i) { u32x4 wo;
#pragma unroll
                  for (int h = 0; h < 2; ++h) {
                      const f32x4 g0 = {bflo(gw_[i][2 * h]), bfhi(gw_[i][2 * h]), bflo(gw_[i][2 * h + 1]), bfhi(gw_[i][2 * h + 1])};
                      const f32x4 g1 = {bflo(gw_[i + 1][2 * h]), bfhi(gw_[i + 1][2 * h]), bflo(gw_[i + 1][2 * h + 1]), bfhi(gw_[i + 1][2 * h + 1])};
                      const f32x4 g2 = {bflo(gw_[i + 2][2 * h]), bfhi(gw_[i + 2][2 * h]), bflo(gw_[i + 2][2 * h + 1]), bfhi(gw_[i + 2][2 * h + 1])};
                      const f32x4 up = {bflo(uw[i][2 * h]), bfhi(uw[i][2 * h]), bflo(uw[i][2 * h + 1]), bfhi(uw[i][2 * h + 1])};
                      const f32x4 y = cb[h] + cw[0][h] * g0 + cw[1][h] * g1 + cw[2][h] * g2;
                      const f32x4 hv = {gelu_tanh(y[0]) * up[0], gelu_tanh(y[1]) * up[1], gelu_tanh(y[2]) * up[2], gelu_tanh(y[3]) * up[3]};
                      wo[2 * h] = cvtpk(hv[0], hv[1]); wo[2 * h + 1] = cvtpk(hv[2], hv[3]); }
                  *(u32x4*)(UB + (size_t)(r0 + i) * FF + c) = wo; }
          } else {
              const int r = SEQ + rb; const float* h0 = st_conv + (size_t)rb * 2 * FF + c;
              const u32x4 gwv = *(const u32x4*)(GU + (size_t)r * FF + c), uwv = *(const u32x4*)(UB + (size_t)r * FF + c); u32x4 wo;
#pragma unroll
              for (int h = 0; h < 2; ++h) {
                  const f32x4 g0 = *(const f32x4*)(h0 + 4 * h), g1 = *(const f32x4*)(h0 + FF + 4 * h);
                  const f32x4 g2 = {bflo(gwv[2 * h]), bfhi(gwv[2 * h]), bflo(gwv[2 * h + 1]), bfhi(gwv[2 * h + 1])};
                  const f32x4 up = {bflo(uwv[2 * h]), bfhi(uwv[2 * h]), bflo(uwv[2 * h + 1]), bfhi(uwv[2 * h + 1])};
                  const f32x4 y = cb[h] + cw[0][h] * g0 + cw[1][h] * g1 + cw[2][h] * g2;
                  const f32x4 hv = {gelu_tanh(y[0]) * up[0], gelu_tanh(y[1]) * up[1], gelu_tanh(y[2]) * up[2], gelu_tanh(y[3]) * up[3]};
                  wo[2 * h] = cvtpk(hv[0], hv[1]); wo[2 * h + 1] = cvtpk(hv[2], hv[3]); }
              *(u32x4*)(UB + (size_t)r * FF + c) = wo;
          }
      } }
    GRID_SYNC();

    {
        unsigned* ctl = (unsigned*)(ws + WS_CTL); float* rs2 = (float*)(ctl + CW_PS2);
        if (G == 256) { pg8::Gemm g{UB, WdT, FF, FF, FF, 0}; pg8::StaticOrder S; S.init(SEQ, DM, G, bx); EpiDownLN E{Y, lds + 131072, rs2, ctl + CW_CNT + 4096, ln2g, ln2b}; pg8::gemm_phase<EpiDownLN>(lds, g, S, E, wave); }
        { FRESH_IDS
          if (G == 256) { const int id = bx; const int r0 = SEQ + 32 * (id & 3), c0 = 32 * (id >> 2);
              const f32x2 v = thin_unit(lds, wave, lane, UB + (size_t)r0 * FF, FF, WdT + (size_t)c0 * FF, FF, FF);
              const int r = r0 + (tid >> 4), c = c0 + 2 * (tid & 15);
              float* yp = Y + (size_t)r * DM + c;
              const f32x2 z = ln_thin(*(const f32x2*)yp * ALPHA + v, r, tid, (float*)(ctl + CW_TS2), ctl + CW_CNT + 6144 + 64 * (id & 3));
              *(f32x2*)yp = z * *(const f32x2*)(ln2g + c) + *(const f32x2*)(ln2b + c); } }
    }
}

extern "C" void kernel_launch(void* const* d_in, const int* in_sizes, int n_in, void* d_out, int out_size, void* d_ws, size_t ws_size, hipStream_t stream) {
    static int grid = 0;
    if (grid == 0) {
        if (n_in != 22 || ws_size < WS_TOTAL) { fprintf(stderr, "kernel_launch: need 22 inputs and >= %zu bytes of workspace (got %d, %zu)\n", (size_t)WS_TOTAL, n_in, ws_size); grid = -1; return; }
        int dev = 0, cus = 0, per_cu = 0;
        (void)hipGetDevice(&dev); (void)hipDeviceGetAttribute(&cus, hipDeviceAttributeMultiprocessorCount, dev);
        (void)hipFuncSetAttribute((const void*)mega_fwd, hipFuncAttributeMaxDynamicSharedMemorySize, LDS_BYTES);
        if (hipOccupancyMaxActiveBlocksPerMultiprocessor(&per_cu, (const void*)mega_fwd, 512, LDS_BYTES) != hipSuccess || per_cu < 1) { fprintf(stderr, "kernel_launch: occupancy query says %d blocks per CU\n", per_cu); per_cu = 1; }
        (void)hipGetLastError();
        grid = cus;
    }
    if (grid < 0) return;
    (void)hipMemsetAsync((char*)d_ws + WS_CTL, 0, CTL_BYTES, stream);
    Args a{};
    for (int i = 0; i < 22; ++i) a.in[i] = (const float*)d_in[i];
    a.out = (float*)d_out; a.ws = (unsigned char*)d_ws;
    void* args[] = {&a};
    hipError_t e = hipLaunchCooperativeKernel((const void*)mega_fwd, dim3(grid), dim3(512), args, LDS_BYTES, stream);
    if (e != hipSuccess) fprintf(stderr, "cooperative launch failed: %s (grid %d)\n", hipGetErrorString(e), grid);
}
```

```cpp
#include <hip/hip_runtime.h>
#include <hip/hip_cooperative_groups.h>
#include <cstdio>
#include <cstdint>
namespace cg = cooperative_groups;

#define LAS __attribute__((address_space(3)))
typedef unsigned short bf16_t;
typedef short bf16x8 __attribute__((ext_vector_type(8)));
typedef float f32x4 __attribute__((ext_vector_type(4)));
typedef float f32x2 __attribute__((ext_vector_type(2)));
typedef float f32x16 __attribute__((ext_vector_type(16)));
typedef unsigned u32x4 __attribute__((ext_vector_type(4)));
typedef unsigned u32x2 __attribute__((ext_vector_type(2)));
typedef __bf16 bf16x2_t __attribute__((ext_vector_type(2)));
typedef _Float16 h2_t __attribute__((ext_vector_type(2)));

constexpr int DM = 2048, SEQ = 8192, NSMP = 128, MR = SEQ + NSMP  , MP = 8448  ;
constexpr int KVD = 256, PW = 1024, FF = 5632, IND = 7680, NH = 32, HD = 64;
constexpr float LN_EPS = 1e-5f;
constexpr float LOG2E = 1.4426950408889634f;
constexpr float QSCALE = 0.125f * LOG2E;
constexpr float ALPHA = 1.189207115002721f;

constexpr size_t O_Y = 0, O_KP = 17039360, O_VP = 17072128, O_PP = 17104896, O_CP = 17120256, O_KS = 17131520, O_VS = 21325824, O_PS = 25520128, O_CS = 27486208;

constexpr size_t MiB = 1u << 20;
constexpr size_t WS_WGU = 0, WS_WD = 44 * MiB, WS_R1 = 66 * MiB  , WS_EARLY = 99 * MiB;
constexpr size_t WS_WIN = WS_EARLY, WS_WAB = WS_WIN + 30 * MiB, WS_WPB = WS_WAB + 8 * MiB, WS_WMIX = WS_WPB + 4 * MiB, WS_WO = WS_WMIX + 1 * MiB;
constexpr size_t WS_R2 = WS_WO + 8 * MiB  , WS_U = WS_R2 + 33 * MiB, WS_SG = WS_U + 33 * MiB  , WS_KB = WS_SG + 66 * MiB, WS_VB = WS_KB + 5 * MiB;
constexpr size_t WS_DP = WS_VB + 5 * MiB  , WS_PY = WS_DP + 33 * MiB  , WS_COS = WS_PY + 8 * MiB, WS_SIN = WS_COS + 2 * MiB, WS_END = WS_SIN + 2 * MiB;
constexpr size_t WS_GU = WS_EARLY;
static_assert(WS_END == 337 * MiB, "ws map");
constexpr size_t WS_CTL = WS_END, CTL_BYTES = 262144, WS_TOTAL = WS_CTL + CTL_BYTES;
constexpr int CW_RS1 = 4096, CW_RS2 = 21504, CW_CNT = 38912, CW_TS1 = 49152, CW_TS2 = 53248;
static_assert((CW_TS2 + 4096) * 4 <= (int)CTL_BYTES, "ctl map 2");
constexpr int CW_UNUSED_ = 0;
static_assert((CW_CNT + 6400) * 4 <= (int)CTL_BYTES && CW_RS1 + 2 * 8320 <= CW_RS2 && CW_RS2 + 2 * 8320 <= CW_CNT, "ctl map");
static_assert(WS_GU + (size_t)MP * 2 * FF * 2 <= WS_END, "GU overlay");

constexpr int LDS_BYTES = 147456;

__device__ __forceinline__ int lane_fresh() { int l; asm volatile("v_mbcnt_lo_u32_b32 %0, -1, 0\n\tv_mbcnt_hi_u32_b32 %0, -1, %0" : "=v"(l)); return l; }
__device__ __forceinline__ unsigned cvtpk(float lo, float hi) { f32x2 v = {lo, hi}; bf16x2_t b = __builtin_convertvector(v, bf16x2_t); return __builtin_bit_cast(unsigned, b); }
__device__ __forceinline__ float bf2f(unsigned short h) { return __builtin_bit_cast(float, (unsigned)h << 16); }
__device__ __forceinline__ float bflo(unsigned w) { return __builtin_bit_cast(float, w << 16); }
__device__ __forceinline__ float bfhi(unsigned w) { return __builtin_bit_cast(float, w & 0xffff0000u); }
__device__ __forceinline__ unsigned pkh(float a, float b) { h2_t v = {(_Float16)a, (_Float16)b}; return __builtin_bit_cast(unsigned, v); }
__device__ __forceinline__ float hlo(unsigned w) { h2_t v = __builtin_bit_cast(h2_t, w); return (float)v.x; }
__device__ __forceinline__ float hhi(unsigned w) { h2_t v = __builtin_bit_cast(h2_t, w); return (float)v.y; }
__device__ __forceinline__ float sigmoidf_(float v) { return __builtin_amdgcn_rcpf(1.f + __builtin_amdgcn_exp2f(-1.4426950408889634f * v)); }

namespace pg8 {
constexpr int BM = 256, BK = 64, HALF = 128, HTB = HALF * BK * 2, STAGE_BYTES = 8 * HTB, NXCD = 8, WGM = 8;
__host__ __device__ __forceinline__ int lds_byte(int r, int c) { const int st = (r >> 4) * 2 + (c >> 5), rr = r & 15, cc = c & 31, ob = rr * 64 + cc * 2; return st * 1024 + (ob ^ (((ob >> 9) & 1) << 5)); }
__host__ __device__ __forceinline__ void stage_rc(int b, int& R, int& C) { const int st = b / 1024, sb = b % 1024, swz = sb ^ (((sb >> 9) & 1) << 5); R = (st >> 1) * 16 + swz / 64; C = (st & 1) * 32 + (swz % 64) / 2; }
__host__ __device__ __forceinline__ int perm32(int rho) { const int n = rho >> 4, i = rho & 15; return 8 * (i >> 2) + 4 * n + (i & 3); }
struct Unit { int pm, pn; };
struct Gemm { const bf16_t* A; const bf16_t* Bt; int K, lda, ldb, acol; };
struct StaticOrder {
    int nM, nN, nwg, G, c, wgm;
    __device__ void init(int M, int N, int G_, int c_, int wgm_ = WGM) { nM = M / BM; nN = N / BM; nwg = nM * nN; G = G_; c = c_; wgm = wgm_; }
    __device__ bool next(int i, Unit& u) const {
        const long L = (long)i * G + c; if (L >= nwg) return false;
        int wgid = (int)L; { const int q = nwg / NXCD, r = nwg % NXCD, xcd = wgid % NXCD, off = wgid / NXCD; wgid = (xcd < r ? xcd * (q + 1) : r * (q + 1) + (xcd - r) * q) + off; }
        const int nig = wgm * nN, gid = wgid / nig, fm = gid * wgm, gsz = (nM - fm) < wgm ? (nM - fm) : wgm;
        u.pm = fm + ((wgid % nig) % gsz); u.pn = (wgid % nig) / gsz; return true;
    }
};
template <class Epi>
__device__ __forceinline__ void gemm_phase(LAS unsigned char* lds, const Gemm g, const StaticOrder& S, const Epi& E, int wid) {
    const int lane = lane_fresh(), tid = wid * 64 + lane, wr = wid >> 2, wc = wid & 3, fr = lane & 15, fq = lane >> 4;
    int K = g.K; asm volatile("" : "+s"(K));
    const int nt = K / BK;
    unsigned voffA[2], voffB[2];
#pragma unroll
    for (int i = 0; i < 2; ++i) { int R, C; stage_rc(tid * 16 + i * 8192, R, C); const int Rb = Epi::PERM ? ((R & ~31) + perm32(R & 31)) : R;
        voffA[i] = (unsigned)(R * g.lda + C) * 2u; voffB[i] = (unsigned)(Rb * g.ldb + C) * 2u; }
    const size_t kstep = (size_t)(BK * 2);
    const size_t hsA = (size_t)HALF * g.lda * 2, hsB = (size_t)HALF * g.ldb * 2;
    const unsigned ldsw = (unsigned)wid * 1024u;
    const int aoff = lds_byte(wr * 64 + fr, fq * 8), boff = lds_byte(wc * 32 + fr, fq * 8);
#define PG8_SA(b, h) (((b) * 2 + (h)) * HTB)
#define PG8_SB(b, h) ((4 + (b) * 2 + (h)) * HTB)
#define PG8_STAGE(bufoff, gbase, voff) do { _Pragma("unroll") for (int _i = 0; _i < 2; ++_i) \
        __builtin_amdgcn_global_load_lds((const unsigned*)((const char*)(gbase) + (voff)[_i]), (LAS unsigned*)(lds + (bufoff) + ldsw + _i * 8192), 16, 0, 0); } while (0)
#define PG8_LDA(dst, b, h) do { _Pragma("unroll") for (int m = 0; m < 4; ++m) _Pragma("unroll") for (int k = 0; k < 2; ++k) dst[m][k] = *(const LAS bf16x8*)(lds + PG8_SA(b, h) + aoff + m * 2048 + k * 1024); } while (0)
#define PG8_LDB(dst, b, h) do { _Pragma("unroll") for (int n = 0; n < 2; ++n) _Pragma("unroll") for (int k = 0; k < 2; ++k) dst[n][k] = *(const LAS bf16x8*)(lds + PG8_SB(b, h) + boff + n * 2048 + k * 1024); } while (0)
#define PG8_MMA(ai, bj, At, Bt) do { __builtin_amdgcn_s_setprio(1); _Pragma("unroll") for (int m = 0; m < 4; ++m) _Pragma("unroll") for (int n = 0; n < 2; ++n) _Pragma("unroll") for (int k = 0; k < 2; ++k) \
        acc[ai][bj][m][n] = __builtin_amdgcn_mfma_f32_16x16x32_bf16(Bt[n][k], At[m][k], acc[ai][bj][m][n], 0, 0, 0); __builtin_amdgcn_s_setprio(0); } while (0)
#define PG8_WAIT_V(n) asm volatile("s_waitcnt vmcnt(" #n ")" ::: "memory")
#define PG8_WAIT_L(n) asm volatile("s_waitcnt lgkmcnt(" #n ")" ::: "memory")
#define PG8_BAR __builtin_amdgcn_s_barrier()
#define PG8_SCHED __builtin_amdgcn_sched_barrier(0)
    Unit cur, nxt; int ui = 0;
    if (!S.next(0, cur)) return;
    f32x4 acc[2][2][4][2];
#pragma unroll
    for (int a = 0; a < 2; ++a)
#pragma unroll
        for (int b = 0; b < 2; ++b)
#pragma unroll
            for (int m = 0; m < 4; ++m)
#pragma unroll
                for (int n = 0; n < 2; ++n) acc[a][b][m][n] = (f32x4){0.f, 0.f, 0.f, 0.f};
    bf16x8 At[4][2], B0[2][2], B1[2][2];
    const char* cA = (const char*)g.A + (size_t)cur.pm * 2 * hsA + (size_t)cur.pn * g.acol * 2; const char* cB = (const char*)g.Bt + (size_t)cur.pn * 2 * hsB;
    PG8_STAGE(PG8_SB(0, 0), cB, voffB); PG8_STAGE(PG8_SB(0, 1), cB + hsB, voffB); PG8_STAGE(PG8_SA(0, 0), cA, voffA); PG8_STAGE(PG8_SA(0, 1), cA + hsA, voffA);
    if (wr == 1) PG8_BAR;
    PG8_WAIT_V(2); PG8_BAR;
    PG8_STAGE(PG8_SB(1, 0), cB + kstep, voffB); PG8_STAGE(PG8_SA(1, 0), cA + kstep, voffA); PG8_STAGE(PG8_SB(1, 1), cB + hsB + kstep, voffB);
    PG8_WAIT_V(6); PG8_BAR;
    for (;;) {
        const bool has_next = S.next(ui + 1, nxt);
        const char* nA = has_next ? (const char*)g.A + (size_t)nxt.pm * 2 * hsA + (size_t)nxt.pn * g.acol * 2 : cA; const char* nB = has_next ? (const char*)g.Bt + (size_t)nxt.pn * 2 * hsB : cB;
        for (int t = 0; t < nt; t += 2) {
            const bool last = (t == nt - 2);
            const char* a1 = cA + (size_t)(t + 1) * kstep;
            const char* a2 = last ? nA : cA + (size_t)(t + 2) * kstep; const char* b2 = last ? nB : cB + (size_t)(t + 2) * kstep;
            const char* a3 = a2 + kstep; const char* b3 = b2 + kstep;
            PG8_LDB(B0, 0, 0); PG8_LDB(B1, 0, 1); PG8_SCHED; PG8_LDA(At, 0, 0); PG8_STAGE(PG8_SA(1, 1), a1 + hsA, voffA);
            PG8_WAIT_V(8); PG8_WAIT_L(0); PG8_BAR; PG8_MMA(0, 0, At, B0); PG8_MMA(0, 1, At, B1); PG8_BAR; PG8_SCHED;
            PG8_LDA(At, 0, 1); PG8_STAGE(PG8_SB(0, 0), b2, voffB); PG8_STAGE(PG8_SB(0, 1), b2 + hsB, voffB); PG8_STAGE(PG8_SA(0, 0), a2, voffA);
            PG8_WAIT_V(8); PG8_WAIT_L(0); PG8_BAR; PG8_MMA(1, 0, At, B0); PG8_MMA(1, 1, At, B1); PG8_BAR; PG8_SCHED;
            PG8_LDB(B0, 1, 0); PG8_LDB(B1, 1, 1); PG8_SCHED; PG8_LDA(At, 1, 0); PG8_STAGE(PG8_SA(0, 1), a2 + hsA, voffA);
            PG8_WAIT_V(8); PG8_WAIT_L(0); PG8_BAR; PG8_MMA(0, 0, At, B0); PG8_MMA(0, 1, At, B1); PG8_BAR; PG8_SCHED;
            PG8_LDA(At, 1, 1); PG8_STAGE(PG8_SB(1, 0), b3, voffB); PG8_STAGE(PG8_SB(1, 1), b3 + hsB, voffB); PG8_STAGE(PG8_SA(1, 0), a3, voffA);
            PG8_WAIT_V(8); PG8_WAIT_L(0); PG8_BAR; PG8_MMA(1, 0, At, B0); PG8_MMA(1, 1, At, B1); PG8_BAR; PG8_SCHED;
        }
        if (wr == 0) PG8_BAR;
        E(acc, cur, wr, wc, fr, fq);
        if (!has_next) break;
#pragma unroll
        for (int a = 0; a < 2; ++a)
#pragma unroll
            for (int b = 0; b < 2; ++b)
#pragma unroll
                for (int m = 0; m < 4; ++m)
#pragma unroll
                    for (int n = 0; n < 2; ++n) acc[a][b][m][n] = (f32x4){0.f, 0.f, 0.f, 0.f};
        cur = nxt; cA = nA; cB = nB; ++ui;
        if (wr == 1) PG8_BAR;
    }
    PG8_WAIT_V(0);
    PG8_BAR;
#undef PG8_SA
#undef PG8_SB
#undef PG8_STAGE
#undef PG8_LDA
#undef PG8_LDB
#undef PG8_MMA
#undef PG8_WAIT_V
#undef PG8_WAIT_L
#undef PG8_BAR
#undef PG8_SCHED
}
template <class Epi>
__device__ __forceinline__ void gemm_phase2(LAS unsigned char* lds, const Gemm g, const Gemm g1, const StaticOrder& S, const Epi& E, int wid) {
    const int lane = lane_fresh(), tid = wid * 64 + lane, wr = wid >> 2, wc = wid & 3, fr = lane & 15, fq = lane >> 4;
    int K0 = g.K, K1 = g1.K; asm volatile("" : "+s"(K0), "+s"(K1));
    const int nt0 = K0 / BK, nt1 = K1 / BK;
    unsigned voffA[2], voffB[2];
#pragma unroll
    for (int i = 0; i < 2; ++i) { int R, C; stage_rc(tid * 16 + i * 8192, R, C); const int Rb = Epi::PERM ? ((R & ~31) + perm32(R & 31)) : R;
        voffA[i] = (unsigned)(R * g.lda + C) * 2u; voffB[i] = (unsigned)(Rb * g.ldb + C) * 2u; }
    const size_t kstep = (size_t)(BK * 2);
    const size_t hsA = (size_t)HALF * g.lda * 2, hsB = (size_t)HALF * g.ldb * 2;
    const unsigned ldsw = (unsigned)wid * 1024u;
    const int aoff = lds_byte(wr * 64 + fr, fq * 8), boff = lds_byte(wc * 32 + fr, fq * 8);
#define PG8_SA(b, h) (((b) * 2 + (h)) * HTB)
#define PG8_SB(b, h) ((4 + (b) * 2 + (h)) * HTB)
#define PG8_STAGE(bufoff, gbase, voff) do { _Pragma("unroll") for (int _i = 0; _i < 2; ++_i) \
        __builtin_amdgcn_global_load_lds((const unsigned*)((const char*)(gbase) + (voff)[_i]), (LAS unsigned*)(lds + (bufoff) + ldsw + _i * 8192), 16, 0, 0); } while (0)
#define PG8_LDA(dst, b, h) do { _Pragma("unroll") for (int m = 0; m < 4; ++m) _Pragma("unroll") for (int k = 0; k < 2; ++k) dst[m][k] = *(const LAS bf16x8*)(lds + PG8_SA(b, h) + aoff + m * 2048 + k * 1024); } while (0)
#define PG8_LDB(dst, b, h) do { _Pragma("unroll") for (int n = 0; n < 2; ++n) _Pragma("unroll") for (int k = 0; k < 2; ++k) dst[n][k] = *(const LAS bf16x8*)(lds + PG8_SB(b, h) + boff + n * 2048 + k * 1024); } while (0)
#define PG8_MMA(ai, bj, At, Bt) do { __builtin_amdgcn_s_setprio(1); _Pragma("unroll") for (int m = 0; m < 4; ++m) _Pragma("unroll") for (int n = 0; n < 2; ++n) _Pragma("unroll") for (int k = 0; k < 2; ++k) \
        acc[ai][bj][m][n] = __builtin_amdgcn_mfma_f32_16x16x32_bf16(Bt[n][k], At[m][k], acc[ai][bj][m][n], 0, 0, 0); __builtin_amdgcn_s_setprio(0); } while (0)
#define PG8_WAIT_V(n) asm volatile("s_waitcnt vmcnt(" #n ")" ::: "memory")
#define PG8_WAIT_L(n) asm volatile("s_waitcnt lgkmcnt(" #n ")" ::: "memory")
#define PG8_BAR __builtin_amdgcn_s_barrier()
#define PG8_SCHED __builtin_amdgcn_sched_barrier(0)
    Unit cur, nxt; int ui = 0;
    if (!S.next(0, cur)) return;
#define SEG_A(u_, sg_) ((const char*)((sg_) ? g1.A : g.A) + (size_t)(u_).pm * 2 * hsA)
#define SEG_B(u_, sg_) ((const char*)((sg_) ? g1.Bt : g.Bt) + (size_t)(u_).pn * 2 * hsB)
    f32x4 acc[2][2][4][2];
#pragma unroll
    for (int a = 0; a < 2; ++a)
#pragma unroll
        for (int b = 0; b < 2; ++b)
#pragma unroll
            for (int m = 0; m < 4; ++m)
#pragma unroll
                for (int n = 0; n < 2; ++n) acc[a][b][m][n] = (f32x4){0.f, 0.f, 0.f, 0.f};
    bf16x8 At[4][2], B0[2][2], B1[2][2];
    const char* cA = SEG_A(cur, 0); const char* cB = SEG_B(cur, 0);
    PG8_STAGE(PG8_SB(0, 0), cB, voffB); PG8_STAGE(PG8_SB(0, 1), cB + hsB, voffB); PG8_STAGE(PG8_SA(0, 0), cA, voffA); PG8_STAGE(PG8_SA(0, 1), cA + hsA, voffA);
    if (wr == 1) PG8_BAR;
    PG8_WAIT_V(2); PG8_BAR;
    PG8_STAGE(PG8_SB(1, 0), cB + kstep, voffB); PG8_STAGE(PG8_SA(1, 0), cA + kstep, voffA); PG8_STAGE(PG8_SB(1, 1), cB + hsB + kstep, voffB);
    PG8_WAIT_V(6); PG8_BAR;
    for (;;) {
        const int seg = ui & 1, nt = seg ? nt1 : nt0;
        bool has_next = true; nxt = cur; if (seg) has_next = S.next((ui + 1) >> 1, nxt);
        const char* nA = has_next ? SEG_A(nxt, seg ^ 1) : cA; const char* nB = has_next ? SEG_B(nxt, seg ^ 1) : cB;
        for (int t = 0; t < nt; t += 2) {
            const bool last = (t == nt - 2);
            const char* a1 = cA + (size_t)(t + 1) * kstep;
            const char* a2 = last ? nA : cA + (size_t)(t + 2) * kstep; const char* b2 = last ? nB : cB + (size_t)(t + 2) * kstep;
            const char* a3 = a2 + kstep; const char* b3 = b2 + kstep;
            PG8_LDB(B0, 0, 0); PG8_LDB(B1, 0, 1); PG8_SCHED; PG8_LDA(At, 0, 0); PG8_STAGE(PG8_SA(1, 1), a1 + hsA, voffA);
            PG8_WAIT_V(8); PG8_WAIT_L(0); PG8_BAR; PG8_MMA(0, 0, At, B0); PG8_MMA(0, 1, At, B1); PG8_BAR; PG8_SCHED;
            PG8_LDA(At, 0, 1); PG8_STAGE(PG8_SB(0, 0), b2, voffB); PG8_STAGE(PG8_SB(0, 1), b2 + hsB, voffB); PG8_STAGE(PG8_SA(0, 0), a2, voffA);
            PG8_WAIT_V(8); PG8_WAIT_L(0); PG8_BAR; PG8_MMA(1, 0, At, B0); PG8_MMA(1, 1, At, B1); PG8_BAR; PG8_SCHED;
            PG8_LDB(B0, 1, 0); PG8_LDB(B1, 1, 1); PG8_SCHED; PG8_LDA(At, 1, 0); PG8_STAGE(PG8_SA(0, 1), a2 + hsA, voffA);
            PG8_WAIT_V(8); PG8_WAIT_L(0); PG8_BAR; PG8_MMA(0, 0, At, B0); PG8_MMA(0, 1, At, B1); PG8_BAR; PG8_SCHED;
            PG8_LDA(At, 1, 1); PG8_STAGE(PG8_SB(1, 0), b3, voffB); PG8_STAGE(PG8_SB(1, 1), b3 + hsB, voffB); PG8_STAGE(PG8_SA(1, 0), a3, voffA);
            PG8_WAIT_V(8); PG8_WAIT_L(0); PG8_BAR; PG8_MMA(1, 0, At, B0); PG8_MMA(1, 1, At, B1); PG8_BAR; PG8_SCHED;
        }
        if (wr == 0) PG8_BAR;
        if (seg == 0) E.mid(acc, cur, wr, wc, fr, fq); else E(acc, cur, wr, wc, fr, fq);
        if (!has_next) break;
        if (seg)
#pragma unroll
        for (int a = 0; a < 2; ++a)
#pragma unroll
            for (int b = 0; b < 2; ++b)
#pragma unroll
                for (int m = 0; m < 4; ++m)
#pragma unroll
                    for (int n = 0; n < 2; ++n) acc[a][b][m][n] = (f32x4){0.f, 0.f, 0.f, 0.f};
        cur = nxt; cA = nA; cB = nB; ++ui;
        if (wr == 1) PG8_BAR;
    }
    PG8_WAIT_V(0);
    PG8_BAR;
#undef SEG_A
#undef SEG_B
#undef PG8_SA
#undef PG8_SB
#undef PG8_STAGE
#undef PG8_LDA
#undef PG8_LDB
#undef PG8_MMA
#undef PG8_WAIT_V
#undef PG8_WAIT_L
#undef PG8_BAR
#undef PG8_SCHED
}
}
using pg8::Unit;

#define ROW_OF(u, ai, wr, m, fr) ((u).pm * 256 + (ai) * 128 + (wr) * 64 + (m) * 16 + (fr))

struct EpiIn {
    static constexpr bool PERM = true;
    bf16_t* Q; bf16_t* Kb; bf16_t* Vb; float* U; unsigned short* SG; const float* COS; const float* SIN; float* out;
    __device__ __forceinline__ void operator()(const f32x4 (&acc)[2][2][4][2], const Unit& u, int wr, int wc, int fr, int fq) const {
        const int pn = u.pn;
        if (pn <= 8) {
            const float sc = pn < 8 ? QSCALE : 1.f;
            bf16_t* dst = pn < 8 ? Q : Kb; const int ld = pn < 8 ? DM : KVD; const int cb = (pn < 8 ? pn * 256 : 0) + 64 * wc + 8 * fq;
#pragma unroll
            for (int ai = 0; ai < 2; ++ai) {
                f32x4 tc0[4], tc1[4], ts0[4], ts1[4];
#pragma unroll
                for (int m = 0; m < 4; ++m) { const int r = ROW_OF(u, ai, wr, m, fr); const int pos = r < SEQ ? r : SEQ;
                    tc0[m] = *(const f32x4*)(COS + pos * 32 + 8 * fq); tc1[m] = *(const f32x4*)(COS + pos * 32 + 8 * fq + 4);
                    ts0[m] = *(const f32x4*)(SIN + pos * 32 + 8 * fq); ts1[m] = *(const f32x4*)(SIN + pos * 32 + 8 * fq + 4); }
#pragma unroll
                for (int m = 0; m < 4; ++m) {
                    const int r = ROW_OF(u, ai, wr, m, fr);
                    const f32x4 c0 = tc0[m], c1 = tc1[m], s0 = ts0[m], s1 = ts1[m];
                    const f32x4 a0 = acc[ai][0][m][0], a1 = acc[ai][0][m][1], b0 = acc[ai][1][m][0], b1 = acc[ai][1][m][1];
                    const f32x4 o10 = (a0 * c0 - b0 * s0) * sc, o11 = (a1 * c1 - b1 * s1) * sc, o20 = (b0 * c0 + a0 * s0) * sc, o21 = (b1 * c1 + a1 * s1) * sc;
                    u32x4 w1, w2; w1.x = cvtpk(o10[0], o10[1]); w1.y = cvtpk(o10[2], o10[3]); w1.z = cvtpk(o11[0], o11[1]); w1.w = cvtpk(o11[2], o11[3]);
                    w2.x = cvtpk(o20[0], o20[1]); w2.y = cvtpk(o20[2], o20[3]); w2.z = cvtpk(o21[0], o21[1]); w2.w = cvtpk(o21[2], o21[3]);
                    *(u32x4*)(dst + (size_t)r * ld + cb) = w1; *(u32x4*)(dst + (size_t)r * ld + cb + 32) = w2;
                    if (pn == 8) {
                        float* o = nullptr;
                        if (r >= SEQ - 128 && r < SEQ) o = out + O_KP + (size_t)(r - (SEQ - 128)) * 256 + cb;
                        else if (r >= SEQ && r < MR) o = out + O_KS + ((size_t)(r - SEQ) * 128 + 127) * 256 + cb;
                        if (o) { *(f32x4*)o = o10; *(f32x4*)(o + 4) = o11; *(f32x4*)(o + 32) = o20; *(f32x4*)(o + 36) = o21; }
                    }
                }
            }
        } else if (pn == 9) {
#pragma unroll
            for (int ai = 0; ai < 2; ++ai)
#pragma unroll
                for (int m = 0; m < 4; ++m) {
                    const int r = ROW_OF(u, ai, wr, m, fr);
                    float* o = nullptr;
                    if (r >= SEQ - 128 && r < SEQ) o = out + O_VP + (size_t)(r - (SEQ - 128)) * 256;
                    else if (r >= SEQ && r < MR) o = out + O_VS + ((size_t)(r - SEQ) * 128 + 127) * 256;
#pragma unroll
                    for (int bj = 0; bj < 2; ++bj) { const int c = 128 * bj + 32 * wc + 8 * fq; const f32x4 v0 = acc[ai][bj][m][0], v1 = acc[ai][bj][m][1];
                        u32x4 w; w.x = cvtpk(v0[0], v0[1]); w.y = cvtpk(v0[2], v0[3]); w.z = cvtpk(v1[0], v1[1]); w.w = cvtpk(v1[2], v1[3]);
                        *(u32x4*)(Vb + (size_t)r * KVD + c) = w;
                        if (o) { *(f32x4*)(o + c) = v0; *(f32x4*)(o + c + 4) = v1; } }
                }
        } else if (pn < 14) {
#pragma unroll
            for (int ai = 0; ai < 2; ++ai)
#pragma unroll
                for (int m = 0; m < 4; ++m) {
                    const int r = ROW_OF(u, ai, wr, m, fr);
                    float* o = nullptr;
                    if (r >= SEQ - 15 && r < SEQ) o = out + O_PP + (size_t)(r - (SEQ - 15)) * PW;
                    else if (r >= SEQ && r < MR) o = out + O_PS + ((size_t)(r - SEQ) * 15 + 14) * PW;
#pragma unroll
                    for (int bj = 0; bj < 2; ++bj) { const int c = (pn - 10) * 256 + 128 * bj + 32 * wc + 8 * fq; const f32x4 v0 = acc[ai][bj][m][0], v1 = acc[ai][bj][m][1];
                        *(f32x4*)(U + (size_t)r * PW + c) = v0; *(f32x4*)(U + (size_t)r * PW + c + 4) = v1;
                        if (o) { *(f32x4*)(o + c) = v0; *(f32x4*)(o + c + 4) = v1; } }
                }
        } else {
#pragma unroll
            for (int ai = 0; ai < 2; ++ai)
#pragma unroll
                for (int m = 0; m < 4; ++m) {
                    const int r = ROW_OF(u, ai, wr, m, fr);
#pragma unroll
                    for (int bj = 0; bj < 2; ++bj) { const int c = (pn - 14) * 256 + 128 * bj + 32 * wc + 8 * fq; const f32x4 v0 = acc[ai][bj][m][0], v1 = acc[ai][bj][m][1];
                        u32x4 w; w.x = pkh(sigmoidf_(v0[0]), sigmoidf_(v0[1])); w.y = pkh(sigmoidf_(v0[2]), sigmoidf_(v0[3])); w.z = pkh(sigmoidf_(v1[0]), sigmoidf_(v1[1])); w.w = pkh(sigmoidf_(v1[2]), sigmoidf_(v1[3]));
                        *(u32x4*)(SG + (size_t)r * 4096 + c) = w; }
                }
        }
    }
};
struct EpiMix {
    static constexpr bool PERM = true;
    bf16_t* PY; const float* scale;
    __device__ __forceinline__ void operator()(const f32x4 (&acc)[2][2][4][2], const Unit& u, int wr, int wc, int fr, int fq) const {
#pragma unroll
        for (int bj = 0; bj < 2; ++bj) { const int c = u.pn * 256 + 128 * bj + 32 * wc + 8 * fq; const f32x4 s0 = *(const f32x4*)(scale + c), s1 = *(const f32x4*)(scale + c + 4);
#pragma unroll
            for (int ai = 0; ai < 2; ++ai)
#pragma unroll
                for (int m = 0; m < 4; ++m) { const int r = ROW_OF(u, ai, wr, m, fr); const f32x4 v0 = acc[ai][bj][m][0] * s0, v1 = acc[ai][bj][m][1] * s1;
                    u32x4 w; w.x = cvtpk(v0[0], v0[1]); w.y = cvtpk(v0[2], v0[3]); w.z = cvtpk(v1[0], v1[1]); w.w = cvtpk(v1[2], v1[3]);
                    *(u32x4*)(PY + (size_t)r * PW + c) = w; } }
    }
};
struct EpiWeff {
    static constexpr bool PERM = true;
    bf16_t* W;
    __device__ __forceinline__ void operator()(const f32x4 (&acc)[2][2][4][2], const Unit& u, int wr, int wc, int fr, int fq) const {
#pragma unroll
        for (int bj = 0; bj < 2; ++bj) { const int c = u.pn * 256 + 128 * bj + 32 * wc + 8 * fq;
#pragma unroll
            for (int ai = 0; ai < 2; ++ai)
#pragma unroll
                for (int m = 0; m < 4; ++m) { const int r = ROW_OF(u, ai, wr, m, fr); const f32x4 v0 = acc[ai][bj][m][0], v1 = acc[ai][bj][m][1];
                    u32x4 w; w.x = cvtpk(v0[0], v0[1]); w.y = cvtpk(v0[2], v0[3]); w.z = cvtpk(v1[0], v1[1]); w.w = cvtpk(v1[2], v1[3]);
                    *(u32x4*)(W + (size_t)r * DM + c) = w; } }
    }
};
struct EpiBrA {
    static constexpr bool PERM = false;
    float* T1; const unsigned short* SG;
    __device__ __forceinline__ void operator()(const f32x4 (&acc)[2][2][4][2], const Unit& u, int wr, int wc, int fr, int fq) const {
#pragma unroll
        for (int ai = 0; ai < 2; ++ai)
#pragma unroll
            for (int m = 0; m < 4; ++m) { const int r = ROW_OF(u, ai, wr, m, fr); if (r < MR) {
#pragma unroll
                for (int bj = 0; bj < 2; ++bj)
#pragma unroll
                    for (int n = 0; n < 2; ++n) { const int c = u.pn * 256 + 128 * bj + 32 * wc + 16 * n + 4 * fq; const u32x2 gw = *(const u32x2*)(SG + (size_t)r * 4096 + c);
                        const f32x4 gt = {hlo(gw.x), hhi(gw.x), hlo(gw.y), hhi(gw.y)}; *(f32x4*)(T1 + (size_t)r * DM + c) = acc[ai][bj][m][n] * gt; } } }
    }
};
struct EpiBrB {
    static constexpr bool PERM = false;
    const float* T1; const unsigned short* SG; bf16_t* MG;
    __device__ __forceinline__ void operator()(const f32x4 (&acc)[2][2][4][2], const Unit& u, int wr, int wc, int fr, int fq) const {
#pragma unroll
        for (int ai = 0; ai < 2; ++ai)
#pragma unroll
            for (int m = 0; m < 4; ++m) { const int r = ROW_OF(u, ai, wr, m, fr);
#pragma unroll
                for (int bj = 0; bj < 2; ++bj)
#pragma unroll
                    for (int n = 0; n < 2; ++n) { const int c = u.pn * 256 + 128 * bj + 32 * wc + 16 * n + 4 * fq; f32x4 o = {0.f, 0.f, 0.f, 0.f};
                        if (r < MR) { const u32x2 gw = *(const u32x2*)(SG + (size_t)r * 4096 + 2048 + c); const f32x4 gt = {hlo(gw.x), hhi(gw.x), hlo(gw.y), hhi(gw.y)};
                            o = *(const f32x4*)(T1 + (size_t)r * DM + c) + acc[ai][bj][m][n] * gt; }
                        u32x2 w; w.x = cvtpk(o[0], o[1]); w.y = cvtpk(o[2], o[3]); *(u32x2*)(MG + (size_t)r * DM + c) = w; } }
    }
};
struct EpiBr {
    static constexpr bool PERM = false;
    const unsigned short* SG; bf16_t* MG;
    __device__ __forceinline__ void mid(f32x4 (&acc)[2][2][4][2], const Unit& u, int wr, int wc, int fr, int fq) const {
        unsigned o0 = (unsigned)((u.pm * 256 + wr * 64 + fr) * 4096 + u.pn * 256 + 32 * wc + 4 * fq) * 2u; asm volatile("" : "+v"(o0)); const char* sb = (const char*)SG;
#pragma unroll
        for (int ai = 0; ai < 2; ++ai) {
            u32x2 gp[4][2][2], ga[4][2][2];
#pragma unroll
            for (int m = 0; m < 4; ++m)
#pragma unroll
                for (int bj = 0; bj < 2; ++bj)
#pragma unroll
                    for (int n = 0; n < 2; ++n) { const unsigned o = o0 + (unsigned)(((ai * 128 + m * 16) * 4096 + 128 * bj + 16 * n) * 2); gp[m][bj][n] = *(const u32x2*)(sb + o); ga[m][bj][n] = *(const u32x2*)(sb + o + 4096); }
#pragma unroll
            for (int m = 0; m < 4; ++m)
#pragma unroll
                for (int bj = 0; bj < 2; ++bj)
#pragma unroll
                    for (int n = 0; n < 2; ++n) { const u32x2 p_ = gp[m][bj][n], q_ = ga[m][bj][n];
                        f32x4 rt; rt[0] = hlo(p_.x) * __builtin_amdgcn_rcpf(fmaxf(hlo(q_.x), 6.2e-5f)); rt[1] = hhi(p_.x) * __builtin_amdgcn_rcpf(fmaxf(hhi(q_.x), 6.2e-5f));
                        rt[2] = hlo(p_.y) * __builtin_amdgcn_rcpf(fmaxf(hlo(q_.y), 6.2e-5f)); rt[3] = hhi(p_.y) * __builtin_amdgcn_rcpf(fmaxf(hhi(q_.y), 6.2e-5f));
                        acc[ai][bj][m][n] = acc[ai][bj][m][n] * rt; }
            asm volatile("" : "+v"(acc[ai][0][0][0]), "+v"(acc[ai][0][0][1]), "+v"(acc[ai][1][0][0]), "+v"(acc[ai][1][0][1]), "+v"(acc[ai][0][1][0]), "+v"(acc[ai][0][1][1]), "+v"(acc[ai][1][1][0]), "+v"(acc[ai][1][1][1]),
                             "+v"(acc[ai][0][2][0]), "+v"(acc[ai][0][2][1]), "+v"(acc[ai][1][2][0]), "+v"(acc[ai][1][2][1]), "+v"(acc[ai][0][3][0]), "+v"(acc[ai][0][3][1]), "+v"(acc[ai][1][3][0]), "+v"(acc[ai][1][3][1]) :: "memory"); }
    }
    __device__ __forceinline__ void operator()(f32x4 (&acc)[2][2][4][2], const Unit& u, int wr, int wc, int fr, int fq) const {
        unsigned o0 = (unsigned)((u.pm * 256 + wr * 64 + fr) * 4096 + u.pn * 256 + 32 * wc + 4 * fq) * 2u; asm volatile("" : "+v"(o0)); const char* sb = (const char*)SG; char* mb = (char*)MG;
#pragma unroll
        for (int ai = 0; ai < 2; ++ai) {
            u32x2 ga[4][2][2];
#pragma unroll
            for (int m = 0; m < 4; ++m)
#pragma unroll
                for (int bj = 0; bj < 2; ++bj)
#pragma unroll
                    for (int n = 0; n < 2; ++n) { const unsigned o = o0 + (unsigned)(((ai * 128 + m * 16) * 4096 + 128 * bj + 16 * n) * 2); ga[m][bj][n] = *(const u32x2*)(sb + o + 4096); }
#pragma unroll
            for (int m = 0; m < 4; ++m)
#pragma unroll
                for (int bj = 0; bj < 2; ++bj)
#pragma unroll
                    for (int n = 0; n < 2; ++n) { const u32x2 q_ = ga[m][bj][n];
                        const f32x4 q = {fmaxf(hlo(q_.x), 6.2e-5f), fmaxf(hhi(q_.x), 6.2e-5f), fmaxf(hlo(q_.y), 6.2e-5f), fmaxf(hhi(q_.y), 6.2e-5f)};
                        const f32x4 v = acc[ai][bj][m][n] * q; u32x2 w; w.x = cvtpk(v[0], v[1]); w.y = cvtpk(v[2], v[3]);
                        const unsigned row = (unsigned)(u.pm * 256 + wr * 64 + fr + ai * 128 + m * 16), col = (unsigned)(u.pn * 256 + 32 * wc + 4 * fq + 128 * bj + 16 * n);
                        *(u32x2*)(mb + ((size_t)row * DM + col) * 2) = w; }
            asm volatile("" ::: "memory"); }
    }
};
struct EpiOut {
    static constexpr bool PERM = false;
    const float* xp; const float* xs; float* H1;
    __device__ __forceinline__ void operator()(const f32x4 (&acc)[2][2][4][2], const Unit& u, int wr, int wc, int fr, int fq) const {
#pragma unroll
        for (int ai = 0; ai < 2; ++ai)
#pragma unroll
            for (int m = 0; m < 4; ++m) { const int r = ROW_OF(u, ai, wr, m, fr); if (r < MR) { const float* xr = r < SEQ ? xp + (size_t)r * DM : xs + (size_t)(r - SEQ) * DM;
#pragma unroll
                for (int bj = 0; bj < 2; ++bj)
#pragma unroll
                    for (int n = 0; n < 2; ++n) { const int c = u.pn * 256 + 128 * bj + 32 * wc + 16 * n + 4 * fq;
                        *(f32x4*)(H1 + (size_t)r * DM + c) = *(const f32x4*)(xr + c) * ALPHA + acc[ai][bj][m][n]; } } }
    }
};

__device__ __forceinline__ void ln_tile(f32x4 (&v)[2][2][4][2], const Unit& u, int wr, int wc, int fr, int fq, LAS unsigned char* lx, float* rowstat, unsigned* cnt, unsigned want, const float* gam, const float* bet) {
    LAS f32x2* P = (LAS f32x2*)lx; LAS f32x2* S = (LAS f32x2*)(lx + 8192);
    const int tid = (wr * 4 + wc) * 64 + fq * 16 + fr;
#pragma unroll
    for (int ai = 0; ai < 2; ++ai)
#pragma unroll
        for (int m = 0; m < 4; ++m) { float s = 0.f, q = 0.f;
#pragma unroll
            for (int bj = 0; bj < 2; ++bj)
#pragma unroll
                for (int n = 0; n < 2; ++n) { const f32x4 x = v[ai][bj][m][n]; s += (x[0] + x[1]) + (x[2] + x[3]); q += (x[0] * x[0] + x[1] * x[1]) + (x[2] * x[2] + x[3] * x[3]); }
            s += __shfl_xor(s, 16); s += __shfl_xor(s, 32); q += __shfl_xor(q, 16); q += __shfl_xor(q, 32);
            if (fq == 0) P[(ai * 128 + wr * 64 + m * 16 + fr) * 4 + wc] = (f32x2){s, q}; }
    __syncthreads();
    if (tid < 256) { const f32x2 a = P[tid * 4 + 0], b = P[tid * 4 + 1], c = P[tid * 4 + 2], d = P[tid * 4 + 3];
        float* rs = rowstat + (size_t)(u.pm * 256 + tid) * 2;
        (void)__hip_atomic_fetch_add(rs, (a[0] + b[0]) + (c[0] + d[0]), __ATOMIC_RELAXED, __HIP_MEMORY_SCOPE_AGENT);
        (void)__hip_atomic_fetch_add(rs + 1, (a[1] + b[1]) + (c[1] + d[1]), __ATOMIC_RELAXED, __HIP_MEMORY_SCOPE_AGENT); }
    asm volatile("s_waitcnt vmcnt(0)" ::: "memory");
    __syncthreads();
    if (tid == 0) { (void)__hip_atomic_fetch_add(cnt, 1u, __ATOMIC_RELAXED, __HIP_MEMORY_SCOPE_AGENT);
        unsigned sp = 0; while (__hip_atomic_load(cnt, __ATOMIC_RELAXED, __HIP_MEMORY_SCOPE_AGENT) < want) { __builtin_amdgcn_s_sleep(1); if (++sp > (1u << 22)) break; }
        asm volatile("s_waitcnt vmcnt(0)" ::: "memory"); }
    __syncthreads();
    if (tid < 256) { float* rs = rowstat + (size_t)(u.pm * 256 + tid) * 2;
        const float sm = __hip_atomic_load(rs, __ATOMIC_RELAXED, __HIP_MEMORY_SCOPE_AGENT), sq = __hip_atomic_load(rs + 1, __ATOMIC_RELAXED, __HIP_MEMORY_SCOPE_AGENT);
        const float mean = sm * (1.f / DM), var = sq * (1.f / DM) - mean * mean; S[tid] = (f32x2){mean, 1.f / sqrtf(fmaxf(var, 0.f) + LN_EPS)}; }
    __syncthreads();
#pragma unroll
    for (int bj = 0; bj < 2; ++bj)
#pragma unroll
        for (int n = 0; n < 2; ++n) { const int c = u.pn * 256 + 128 * bj + 32 * wc + 16 * n + 4 * fq; const f32x4 g = *(const f32x4*)(gam + c), b = *(const f32x4*)(bet + c);
#pragma unroll
            for (int ai = 0; ai < 2; ++ai)
#pragma unroll
                for (int m = 0; m < 4; ++m) { const f32x2 st = S[ai * 128 + wr * 64 + m * 16 + fr]; v[ai][bj][m][n] = (v[ai][bj][m][n] - st[0]) * st[1] * g + b; } }
}
__device__ __forceinline__ unsigned tile_off0(const Unit& u, int wr, int wc, int fr, int fq) { unsigned o = (unsigned)((u.pm * 256 + wr * 64 + fr) * DM + u.pn * 256 + 32 * wc + 4 * fq) * 4u; asm volatile("" : "+v"(o)); return o; }
#define TILE_OFF(o0, ai, m, bj, n) ((o0) + (unsigned)(((ai) * 128 + (m) * 16) * DM * 4 + (128 * (bj) + 16 * (n)) * 4))
struct EpiOutLN {
    static constexpr bool PERM = false;
    const float* xp; float* Y; bf16_t* XB; LAS unsigned char* lx; float* rowstat; unsigned* cnt; const float* gam; const float* bet;
    __device__ __forceinline__ void operator()(f32x4 (&acc)[2][2][4][2], const Unit& u, int wr, int wc, int fr, int fq) const {
        { const unsigned o0 = tile_off0(u, wr, wc, fr, fq); const char* xb = (const char*)xp;
#pragma unroll
          for (int ai = 0; ai < 2; ++ai)
#pragma unroll
            for (int m = 0; m < 4; ++m) {
#pragma unroll
                for (int bj = 0; bj < 2; ++bj)
#pragma unroll
                    for (int n = 0; n < 2; ++n) acc[ai][bj][m][n] = __builtin_nontemporal_load((const f32x4*)(xb + TILE_OFF(o0, ai, m, bj, n))) * ALPHA + acc[ai][bj][m][n];
                if (m == 3) asm volatile("" : "+v"(acc[ai][0][0][0]), "+v"(acc[ai][0][0][1]), "+v"(acc[ai][1][0][0]), "+v"(acc[ai][1][0][1]), "+v"(acc[ai][0][1][0]), "+v"(acc[ai][0][1][1]), "+v"(acc[ai][1][1][0]), "+v"(acc[ai][1][1][1]),
                                               "+v"(acc[ai][0][2][0]), "+v"(acc[ai][0][2][1]), "+v"(acc[ai][1][2][0]), "+v"(acc[ai][1][2][1]), "+v"(acc[ai][0][3][0]), "+v"(acc[ai][0][3][1]), "+v"(acc[ai][1][3][0]), "+v"(acc[ai][1][3][1]) :: "memory"); } }
        ln_tile(acc, u, wr, wc, fr, fq, lx, rowstat, cnt + 64 * u.pm, 8u, gam, bet);
        { const unsigned o0 = tile_off0(u, wr, wc, fr, fq); char* bb = (char*)XB;
#pragma unroll
          for (int ai = 0; ai < 2; ++ai)
#pragma unroll
            for (int m = 0; m < 4; ++m) {
#pragma unroll
                for (int bj = 0; bj < 2; ++bj)
#pragma unroll
                    for (int n = 0; n < 2; ++n) { const unsigned o = TILE_OFF(o0, ai, m, bj, n); const f32x4 v = acc[ai][bj][m][n];
                        u32x2 w; w.x = cvtpk(v[0], v[1]); w.y = cvtpk(v[2], v[3]); *(u32x2*)(bb + (o >> 1)) = w; }
                asm volatile("" ::: "memory"); } }
    }
};
struct EpiDownLN {
    static constexpr bool PERM = false;
    float* Y; const bf16_t* XB; LAS unsigned char* lx; float* rowstat; unsigned* cnt; const float* gam; const float* bet;
    __device__ __forceinline__ void operator()(f32x4 (&acc)[2][2][4][2], const Unit& u, int wr, int wc, int fr, int fq) const {
        { const unsigned o0 = tile_off0(u, wr, wc, fr, fq); const char* xb = (const char*)XB;
#pragma unroll
          for (int ai = 0; ai < 2; ++ai)
#pragma unroll
            for (int m = 0; m < 4; ++m) {
#pragma unroll
                for (int bj = 0; bj < 2; ++bj)
#pragma unroll
                    for (int n = 0; n < 2; ++n) { const u32x2 xw = __builtin_nontemporal_load((const u32x2*)(xb + (TILE_OFF(o0, ai, m, bj, n) >> 1))); const f32x4 xv = {bflo(xw.x), bfhi(xw.x), bflo(xw.y), bfhi(xw.y)}; acc[ai][bj][m][n] = xv * ALPHA + acc[ai][bj][m][n]; }
                if (m == 3) asm volatile("" : "+v"(acc[ai][0][0][0]), "+v"(acc[ai][0][0][1]), "+v"(acc[ai][1][0][0]), "+v"(acc[ai][1][0][1]), "+v"(acc[ai][0][1][0]), "+v"(acc[ai][0][1][1]), "+v"(acc[ai][1][1][0]), "+v"(acc[ai][1][1][1]),
                                               "+v"(acc[ai][0][2][0]), "+v"(acc[ai][0][2][1]), "+v"(acc[ai][1][2][0]), "+v"(acc[ai][1][2][1]), "+v"(acc[ai][0][3][0]), "+v"(acc[ai][0][3][1]), "+v"(acc[ai][1][3][0]), "+v"(acc[ai][1][3][1]) :: "memory"); } }
        ln_tile(acc, u, wr, wc, fr, fq, lx, rowstat, cnt + 64 * u.pm, 8u, gam, bet);
        { const unsigned o0 = tile_off0(u, wr, wc, fr, fq); char* yb = (char*)Y;
#pragma unroll
          for (int ai = 0; ai < 2; ++ai)
#pragma unroll
            for (int m = 0; m < 4; ++m) {
#pragma unroll
                for (int bj = 0; bj < 2; ++bj)
#pragma unroll
                    for (int n = 0; n < 2; ++n) __builtin_nontemporal_store(acc[ai][bj][m][n], (f32x4*)(yb + TILE_OFF(o0, ai, m, bj, n)));
                asm volatile("" ::: "memory"); } }
    }
};
__device__ __forceinline__ f32x2 ln_thin(f32x2 h, int r, int tid, float* rowstat, unsigned* cnt) {
    float s = h[0] + h[1], q = h[0] * h[0] + h[1] * h[1];
#pragma unroll
    for (int o = 1; o < 16; o <<= 1) { s += __shfl_xor(s, o); q += __shfl_xor(q, o); }
    if ((tid & 15) == 0) { (void)__hip_atomic_fetch_add(rowstat + (size_t)(r - SEQ) * 32, s, __ATOMIC_RELAXED, __HIP_MEMORY_SCOPE_AGENT); (void)__hip_atomic_fetch_add(rowstat + (size_t)(r - SEQ) * 32 + 1, q, __ATOMIC_RELAXED, __HIP_MEMORY_SCOPE_AGENT); }
    asm volatile("s_waitcnt vmcnt(0)" ::: "memory");
    __syncthreads();
    if (tid == 0) { (void)__hip_atomic_fetch_add(cnt, 1u, __ATOMIC_RELAXED, __HIP_MEMORY_SCOPE_AGENT);
        unsigned sp = 0; while (__hip_atomic_load(cnt, __ATOMIC_RELAXED, __HIP_MEMORY_SCOPE_AGENT) < 64u) { __builtin_amdgcn_s_sleep(1); if (++sp > (1u << 22)) break; }
        asm volatile("s_waitcnt vmcnt(0)" ::: "memory"); }
    __syncthreads();
    const float sm = __hip_atomic_load(rowstat + (size_t)(r - SEQ) * 32, __ATOMIC_RELAXED, __HIP_MEMORY_SCOPE_AGENT), sq = __hip_atomic_load(rowstat + (size_t)(r - SEQ) * 32 + 1, __ATOMIC_RELAXED, __HIP_MEMORY_SCOPE_AGENT);
    const float mean = sm * (1.f / DM), var = sq * (1.f / DM) - mean * mean, rstd = 1.f / sqrtf(fmaxf(var, 0.f) + LN_EPS);
    return (h - mean) * rstd;
}
struct EpiGU {
    static constexpr bool PERM = true;
    bf16_t* GU; float* out;
    __device__ __forceinline__ void operator()(const f32x4 (&acc)[2][2][4][2], const Unit& u, int wr, int wc, int fr, int fq) const {
#pragma unroll
        for (int ai = 0; ai < 2; ++ai)
#pragma unroll
            for (int m = 0; m < 4; ++m) { const int r = ROW_OF(u, ai, wr, m, fr);
                float* o = nullptr;
                if (u.pn < 22) { if (r >= SEQ - 2 && r < SEQ) o = out + O_CP + (size_t)(r - (SEQ - 2)) * FF; else if (r >= SEQ && r < MR) o = out + O_CS + ((size_t)(r - SEQ) * 2 + 1) * FF; }
#pragma unroll
                for (int bj = 0; bj < 2; ++bj) { const int c = u.pn * 256 + 128 * bj + 32 * wc + 8 * fq; const f32x4 v0 = acc[ai][bj][m][0], v1 = acc[ai][bj][m][1];
                    u32x4 w; w.x = cvtpk(v0[0], v0[1]); w.y = cvtpk(v0[2], v0[3]); w.z = cvtpk(v1[0], v1[1]); w.w = cvtpk(v1[2], v1[3]);
                    *(u32x4*)((u.pn < 22 ? GU + (size_t)r * FF + c : GU + (size_t)MP * FF + (size_t)r * FF + (c - FF))) = w;
                    if (o) { *(f32x4*)(o + c) = v0; *(f32x4*)(o + c + 4) = v1; } } }
    }
};
struct EpiDown {
    static constexpr bool PERM = false;
    float* Y;
    __device__ __forceinline__ void operator()(const f32x4 (&acc)[2][2][4][2], const Unit& u, int wr, int wc, int fr, int fq) const {
#pragma unroll
        for (int ai = 0; ai < 2; ++ai)
#pragma unroll
            for (int m = 0; m < 4; ++m) { const int r = ROW_OF(u, ai, wr, m, fr); if (r < MR) {
#pragma unroll
                for (int bj = 0; bj < 2; ++bj)
#pragma unroll
                    for (int n = 0; n < 2; ++n) { const int c = u.pn * 256 + 128 * bj + 32 * wc + 16 * n + 4 * fq; float* p = Y + (size_t)r * DM + c;
                        *(f32x4*)p = *(const f32x4*)p * ALPHA + acc[ai][bj][m][n]; } } }
    }
};

__device__ __forceinline__ int map_in_row(int c) {
    if (c >= 2304) return c;
    const int t = c & ~255, l = c & 255; return t + 128 * ((l >> 5) & 1) + 32 * (l >> 6) + (l & 31);
}
template <bool MAPIN>
__device__ __forceinline__ void transpose_item(const float* W, int N, bf16_t* WT, int K, int row_off, int k0, int n0, LAS float* scr, int lane) {
    const int kr = lane >> 4, nc = (lane & 15) * 4;
    f32x4 v[16];
#pragma unroll
    for (int i = 0; i < 16; ++i) v[i] = *(const f32x4*)(W + (size_t)(k0 + 4 * i + kr) * N + n0 + nc);
#pragma unroll
    for (int i = 0; i < 16; ++i) { LAS float* s = scr + (4 * i + kr) * 65 + nc; s[0] = v[i][0]; s[1] = v[i][1]; s[2] = v[i][2]; s[3] = v[i][3]; }
    asm volatile("s_waitcnt lgkmcnt(0)" ::: "memory");
    const int c = lane & 7;
#pragma unroll
    for (int j = 0; j < 8; ++j) { const int n = (lane >> 3) + 8 * j; const LAS float* s = scr + (8 * c) * 65 + n;
        u32x4 o; o.x = cvtpk(s[0], s[65]); o.y = cvtpk(s[2 * 65], s[3 * 65]); o.z = cvtpk(s[4 * 65], s[5 * 65]); o.w = cvtpk(s[6 * 65], s[7 * 65]);
        const int orow = MAPIN ? map_in_row(n0 + n) : (n0 + n);
        *(u32x4*)(WT + (size_t)(row_off + orow) * K + k0 + 8 * c) = o; }
    asm volatile("s_waitcnt lgkmcnt(0)" ::: "memory");
}

struct ConvPtrs { const float *w_in, *w_mix, *w_ab, *w_pb, *w_out, *w_gate, *w_up, *w_down; bf16_t *WinT, *WmixT, *WabT, *WpbT, *WoT, *WguT, *WdT; };
constexpr int CI_IN = 32 * 120, CI_MX = 4 * 16, CI_AB = 32 * 32, CI_PB = 16 * 32, CI_O = 32 * 32, CI_G = 32 * 88, CI_UP = 32 * 88, CI_D = 88 * 32;
constexpr int CI_EARLY = CI_IN + CI_PB, CI_ALL = CI_EARLY + CI_AB + CI_O + CI_G + CI_UP + CI_D;
__device__ __forceinline__ void convert_range(const ConvPtrs& P, int lo, int hi, int gw, int NGW, LAS float* scr, int lane) {
#define T_DECODE(IT, W_, N_, WT_, K_, RO_, K0_, N0_, MI_) do { int r_ = (IT); MI_ = 0; \
        if (r_ < CI_IN) { W_ = P.w_in; N_ = IND; WT_ = P.WinT; K_ = DM; RO_ = 0; K0_ = 64 * (r_ / 120); N0_ = 64 * (r_ % 120); MI_ = 1; break; } r_ -= CI_IN; \
        if (r_ < CI_PB) { W_ = P.w_pb; N_ = DM; WT_ = P.WpbT; K_ = PW; RO_ = 0; K0_ = 64 * (r_ / 32); N0_ = 64 * (r_ % 32); break; } r_ -= CI_PB; \
        if (r_ < CI_AB) { W_ = P.w_ab; N_ = DM; WT_ = P.WabT; K_ = DM; RO_ = 0; K0_ = 64 * (r_ / 32); N0_ = 64 * (r_ % 32); break; } r_ -= CI_AB; \
        if (r_ < CI_O) { W_ = P.w_out; N_ = DM; WT_ = P.WoT; K_ = DM; RO_ = 0; K0_ = 64 * (r_ / 32); N0_ = 64 * (r_ % 32); break; } r_ -= CI_O; \
        if (r_ < CI_G) { W_ = P.w_gate; N_ = FF; WT_ = P.WguT; K_ = DM; RO_ = 0; K0_ = 64 * (r_ / 88); N0_ = 64 * (r_ % 88); break; } r_ -= CI_G; \
        if (r_ < CI_UP) { W_ = P.w_up; N_ = FF; WT_ = P.WguT; K_ = DM; RO_ = FF; K0_ = 64 * (r_ / 88); N0_ = 64 * (r_ % 88); break; } r_ -= CI_UP; \
        { W_ = P.w_down; N_ = DM; WT_ = P.WdT; K_ = FF; RO_ = 0; K0_ = 64 * (r_ / 32); N0_ = 64 * (r_ % 32); } } while (0)
    const int kr = lane >> 4, nc = (lane & 15) * 4, cc = lane & 7;
    f32x4 va[16], vb[16];
    struct Desc { const float* W; bf16_t* WT; int N, K, RO, K0, N0, MI; };
    Desc da = {nullptr, nullptr, 0, 0, 0, 0, 0, 0}, db = da;
    int ita = lo + gw, itb = ita + NGW;
#define T_LOAD(V, D) do { _Pragma("unroll") for (int i = 0; i < 16; ++i) V[i] = __builtin_nontemporal_load((const f32x4*)(D.W + (size_t)(D.K0 + 4 * i + kr) * D.N + D.N0 + nc)); } while (0)
#define T_TOLDS(V) do { _Pragma("unroll") for (int i = 0; i < 16; ++i) { LAS float* sp = scr + (4 * i + kr) * 65 + nc; sp[0] = V[i][0]; sp[1] = V[i][1]; sp[2] = V[i][2]; sp[3] = V[i][3]; } } while (0)
#define T_FINISH(D) do { asm volatile("s_waitcnt lgkmcnt(0)" ::: "memory"); \
        _Pragma("unroll") for (int j = 0; j < 8; ++j) { const int n = (lane >> 3) + 8 * j; const LAS float* sp = scr + (8 * cc) * 65 + n; \
            u32x4 o; o.x = cvtpk(sp[0], sp[65]); o.y = cvtpk(sp[2 * 65], sp[3 * 65]); o.z = cvtpk(sp[4 * 65], sp[5 * 65]); o.w = cvtpk(sp[6 * 65], sp[7 * 65]); \
            const int orow = D.MI ? map_in_row(D.N0 + n) : (D.N0 + n); \
            *(u32x4*)(D.WT + (size_t)(D.RO + orow) * D.K + D.K0 + 8 * cc) = o; } \
        asm volatile("s_waitcnt lgkmcnt(0)" ::: "memory"); } while (0)
    if (ita < hi) { T_DECODE(ita, da.W, da.N, da.WT, da.K, da.RO, da.K0, da.N0, da.MI); T_LOAD(va, da); }
    if (itb < hi) { T_DECODE(itb, db.W, db.N, db.WT, db.K, db.RO, db.K0, db.N0, db.MI); T_LOAD(vb, db); }
    while (ita < hi) {
        { T_TOLDS(va); const Desc cur = da; ita += 2 * NGW;
          if (ita < hi) { T_DECODE(ita, da.W, da.N, da.WT, da.K, da.RO, da.K0, da.N0, da.MI); T_LOAD(va, da); }
          T_FINISH(cur); }
        if (itb < hi) { T_TOLDS(vb); const Desc cur = db; itb += 2 * NGW;
          if (itb < hi) { T_DECODE(itb, db.W, db.N, db.WT, db.K, db.RO, db.K0, db.N0, db.MI); T_LOAD(vb, db); }
          T_FINISH(cur); }
    }
#undef T_LOAD
#undef T_TOLDS
#undef T_FINISH
#undef T_DECODE
}

__device__ __forceinline__ float wave_sum(float v) {
#pragma unroll
    for (int o = 1; o < 64; o <<= 1) v += __shfl_xor(v, o);
    return v;
}
__device__ __forceinline__ float wave_max(float v) {
#pragma unroll
    for (int o = 1; o < 64; o <<= 1) v = fmaxf(v, __shfl_xor(v, o));
    return v;
}
__device__ __forceinline__ void ln_row(const float* src, const float* gam, const float* bet, float* dstF, bf16_t* dstB, int lane) {
    f32x4 v[8]; float s = 0.f;
#pragma unroll
    for (int j = 0; j < 8; ++j) { v[j] = *(const f32x4*)(src + 4 * lane + 256 * j); s += (v[j][0] + v[j][1]) + (v[j][2] + v[j][3]); }
    const float mean = wave_sum(s) * (1.f / DM); float q = 0.f;
#pragma unroll
    for (int j = 0; j < 8; ++j) { v[j] = v[j] - mean; q += (v[j][0] * v[j][0] + v[j][1] * v[j][1]) + (v[j][2] * v[j][2] + v[j][3] * v[j][3]); }
    const float rstd = 1.f / sqrtf(wave_sum(q) * (1.f / DM) + LN_EPS);
#pragma unroll
    for (int j = 0; j < 8; ++j) { const f32x4 g = *(const f32x4*)(gam + 4 * lane + 256 * j), b = *(const f32x4*)(bet + 4 * lane + 256 * j); const f32x4 o = v[j] * rstd * g + b;
        *(f32x4*)(dstF + 4 * lane + 256 * j) = o;
        if (dstB) { u32x2 w; w.x = cvtpk(o[0], o[1]); w.y = cvtpk(o[2], o[3]); *(u32x2*)(dstB + 4 * lane + 256 * j) = w; } }
}

__device__ __forceinline__ int crow(int r, int hi) { return (r & 3) + 8 * (r >> 2) + 4 * hi; }
__device__ __forceinline__ void attn_prompt_unit(LAS unsigned char* lds, int tid, int kvh, int qb, const bf16_t* Q, const bf16_t* Kb, const bf16_t* Vb, bf16_t* AO, const float* sinks) {
    const int lane = tid & 63, w = tid >> 6, q = lane & 31, hi = lane >> 5;
    const int q0 = qb * 32, kb0 = q0 - 128, head = kvh * 8 + w;
    LAS unsigned char* Ks = lds; LAS unsigned char* Vt = lds + 23040;
    bf16x8 qf[4]; const bf16_t* qp = Q + (size_t)(q0 + q) * DM + head * 64 + hi * 8;
#pragma unroll
    for (int dc = 0; dc < 4; ++dc) qf[dc] = *(const bf16x8*)(qp + 16 * dc);
    for (int it = tid; it < 1280; it += 512) {
        const int row = it >> 3, ch = it & 7, kp = kb0 + row;
        u32x4 kv = {0u, 0u, 0u, 0u}, vv = {0u, 0u, 0u, 0u};
        if (kp >= 0) { kv = *(const u32x4*)(Kb + (size_t)kp * KVD + kvh * 64 + ch * 8); vv = *(const u32x4*)(Vb + (size_t)kp * KVD + kvh * 64 + ch * 8); }
        *(LAS u32x4*)(Ks + row * 144 + ch * 16) = kv;
#pragma unroll
        for (int e = 0; e < 8; ++e) { const unsigned wv = vv[e >> 1]; *(LAS unsigned short*)(Vt + (8 * ch + e) * 328 + row * 2) = (unsigned short)((e & 1) ? (wv >> 16) : (wv & 0xffffu)); }
    }
    __syncthreads();
    f32x16 p[5];
#pragma unroll
    for (int j = 0; j < 5; ++j) {
        p[j] = (f32x16){0.f, 0.f, 0.f, 0.f, 0.f, 0.f, 0.f, 0.f, 0.f, 0.f, 0.f, 0.f, 0.f, 0.f, 0.f, 0.f};
#pragma unroll
        for (int dc = 0; dc < 4; ++dc) { const bf16x8 kf = *(const LAS bf16x8*)(Ks + (32 * j + q) * 144 + (16 * dc + 8 * hi) * 2); p[j] = __builtin_amdgcn_mfma_f32_32x32x16_bf16(kf, qf[dc], p[j], 0, 0, 0); }
    }
    const int qpos = q0 + q; float mx = -1e30f;
#pragma unroll
    for (int j = 0; j < 5; ++j)
#pragma unroll
        for (int r = 0; r < 16; ++r) { const int kp = kb0 + 32 * j + crow(r, hi); const bool vis = (kp >= 0) && (kp <= qpos) && (kp > qpos - 128);
            const float s = vis ? p[j][r] : -1e30f; p[j][r] = s; mx = fmaxf(mx, s); }
    mx = fmaxf(mx, __shfl_xor(mx, 32)); const float sk = sinks[head] * LOG2E; mx = fmaxf(mx, sk);
    float l = 0.f;
#pragma unroll
    for (int j = 0; j < 5; ++j)
#pragma unroll
        for (int r = 0; r < 16; ++r) { const float e = __builtin_amdgcn_exp2f(p[j][r] - mx); p[j][r] = e; l += e; }
    l += __shfl_xor(l, 32); const float inv = 1.f / (l + __builtin_amdgcn_exp2f(sk - mx));
    f32x16 o[2];
    o[0] = (f32x16){0.f, 0.f, 0.f, 0.f, 0.f, 0.f, 0.f, 0.f, 0.f, 0.f, 0.f, 0.f, 0.f, 0.f, 0.f, 0.f}; o[1] = o[0];
#pragma unroll
    for (int c = 0; c < 10; ++c) { const int j = c >> 1, h8 = (c & 1) * 8;
        u32x4 pw; pw.x = cvtpk(p[j][h8 + 0], p[j][h8 + 1]); pw.y = cvtpk(p[j][h8 + 2], p[j][h8 + 3]); pw.z = cvtpk(p[j][h8 + 4], p[j][h8 + 5]); pw.w = cvtpk(p[j][h8 + 6], p[j][h8 + 7]);
        const bf16x8 pa = __builtin_bit_cast(bf16x8, pw);
#pragma unroll
        for (int dh = 0; dh < 2; ++dh) { const LAS unsigned char* vp = Vt + (32 * dh + q) * 328 + (16 * c + 4 * hi) * 2;
            const u32x2 lo = *(const LAS u32x2*)vp, hh = *(const LAS u32x2*)(vp + 16); u32x4 vw; vw.x = lo.x; vw.y = lo.y; vw.z = hh.x; vw.w = hh.y;
            o[dh] = __builtin_amdgcn_mfma_f32_32x32x16_bf16(__builtin_bit_cast(bf16x8, vw), pa, o[dh], 0, 0, 0); } }
    bf16_t* op = AO + (size_t)(q0 + q) * DM + head * 64;
#pragma unroll
    for (int dh = 0; dh < 2; ++dh)
#pragma unroll
        for (int g4 = 0; g4 < 4; ++g4) { u32x2 wv; wv.x = cvtpk(o[dh][4 * g4] * inv, o[dh][4 * g4 + 1] * inv); wv.y = cvtpk(o[dh][4 * g4 + 2] * inv, o[dh][4 * g4 + 3] * inv);
            *(u32x2*)(op + 32 * dh + 8 * g4 + 4 * hi) = wv; }
    __syncthreads();
}
__device__ __forceinline__ void attn_sample_unit(LAS unsigned char* lds, int tid, int b, int kvh, const bf16_t* Q, const float* KS, const float* VS, bf16_t* AO, const float* sinks) {
    const int lane = tid & 63, w = tid >> 6;
    LAS float* Ksf = (LAS float*)lds; LAS float* Vsf = (LAS float*)(lds + 33280); LAS float* Qs = (LAS float*)(lds + 66048); LAS float* Ss = (LAS float*)(lds + 68096); LAS float* den = (LAS float*)(lds + 72192);
    for (int it = tid; it < 2048; it += 512) { const int key = it >> 4, ch = it & 15; const size_t off = ((size_t)(b * 128 + key)) * 256 + kvh * 64 + 4 * ch;
        const f32x4 kv = *(const f32x4*)(KS + off), vv = *(const f32x4*)(VS + off);
        LAS float* kd = Ksf + key * 65 + 4 * ch; kd[0] = kv[0]; kd[1] = kv[1]; kd[2] = kv[2]; kd[3] = kv[3];
        *(LAS f32x4*)(Vsf + key * 64 + 4 * ch) = vv; }
    { const int h = tid >> 6, d = tid & 63; Qs[h * 64 + d] = bf2f(Q[(size_t)(SEQ + b) * DM + (kvh * 8 + h) * 64 + d]); }
    __syncthreads();
    { const int key = tid & 127, hg = tid >> 7;
#pragma unroll
      for (int hh = 0; hh < 2; ++hh) { const int h = 2 * hg + hh; float s = 0.f;
#pragma unroll 16
          for (int d = 0; d < 64; ++d) s += Qs[h * 64 + d] * Ksf[key * 65 + d];
          Ss[h * 128 + key] = s; } }
    __syncthreads();
    { const int h = w; const float s0 = Ss[h * 128 + lane], s1 = Ss[h * 128 + 64 + lane]; const float sk = sinks[kvh * 8 + h] * LOG2E;
      const float m = fmaxf(wave_max(fmaxf(s0, s1)), sk); const float e0 = __builtin_amdgcn_exp2f(s0 - m), e1 = __builtin_amdgcn_exp2f(s1 - m);
      const float l = wave_sum(e0 + e1); Ss[h * 128 + lane] = e0; Ss[h * 128 + 64 + lane] = e1; if (lane == 0) den[h] = l + __builtin_amdgcn_exp2f(sk - m); }
    __syncthreads();
    { const int h = tid >> 6, d = tid & 63; float o = 0.f;
#pragma unroll 16
      for (int key = 0; key < 128; ++key) o += Ss[h * 128 + key] * Vsf[key * 64 + d];
      o = o / den[h];
      const unsigned pk = cvtpk(o, 0.f); AO[(size_t)(SEQ + b) * DM + (kvh * 8 + h) * 64 + d] = (bf16_t)(pk & 0xffffu); }
    __syncthreads();
}


__device__ __forceinline__ f32x2 thin_unit(LAS unsigned char* lds, int wave, int lane, const bf16_t* A, int lda, const bf16_t* Bt, int ldb, int K) {
    const int fr = lane & 15, fq = lane >> 4, kw = K >> 3;
    const bf16_t* ap = A + (size_t)fr * lda + wave * kw + 8 * fq;
    const bf16_t* bp = Bt + (size_t)fr * ldb + wave * kw + 8 * fq;
    const size_t a16 = (size_t)16 * lda, b16 = (size_t)16 * ldb;
    f32x4 acc[2][2];
#pragma unroll
    for (int i = 0; i < 2; ++i)
#pragma unroll
        for (int j = 0; j < 2; ++j) acc[i][j] = (f32x4){0.f, 0.f, 0.f, 0.f};
#pragma unroll 4
    for (int k = 0; k < kw; k += 64) {
        bf16x8 af[2][2], bfr[2][2];
#pragma unroll
        for (int i = 0; i < 2; ++i)
#pragma unroll
            for (int st = 0; st < 2; ++st) { af[i][st] = *(const bf16x8*)(ap + i * a16 + k + 32 * st); bfr[i][st] = *(const bf16x8*)(bp + i * b16 + k + 32 * st); }
#pragma unroll
        for (int st = 0; st < 2; ++st)
#pragma unroll
            for (int i = 0; i < 2; ++i)
#pragma unroll
                for (int j = 0; j < 2; ++j) acc[i][j] = __builtin_amdgcn_mfma_f32_16x16x32_bf16(af[i][st], bfr[j][st], acc[i][j], 0, 0, 0);
    }
    LAS float* part = (LAS float*)lds;
#pragma unroll
    for (int i = 0; i < 2; ++i)
#pragma unroll
        for (int j = 0; j < 2; ++j)
#pragma unroll
            for (int q = 0; q < 4; ++q) part[wave * 1024 + (16 * i + 4 * fq + q) * 32 + 16 * j + fr] = acc[i][j][q];
    __syncthreads();
    const int t = wave * 64 + lane; f32x2 o = {0.f, 0.f};
#pragma unroll
    for (int w = 0; w < 8; ++w) { const f32x2 v = *(const LAS f32x2*)(part + w * 1024 + (t >> 4) * 32 + 2 * (t & 15)); o += v; }
    __syncthreads();
    return o;
}

template <int W>
__device__ __forceinline__ void pool_item(const float* U, bf16_t* DP, int r0, int c) {
    f32x4 v[16 + W - 1];
#pragma unroll
    for (int i = 0; i < 16 + W - 1; ++i) { const int r = r0 - (W - 1) + i; v[i] = r >= 0 ? *(const f32x4*)(U + (size_t)r * PW + c) : (f32x4){0.f, 0.f, 0.f, 0.f}; }
    f32x4 tot = {0.f, 0.f, 0.f, 0.f};
#pragma unroll
    for (int i = 0; i < W - 1; ++i) tot += v[i];
#pragma unroll
    for (int i = 0; i < 16; ++i) { const int r = r0 + i; tot += v[W - 1 + i]; const float rc = 1.f / (float)(r + 1 < W ? r + 1 : W); const f32x4 d = tot * rc - v[W - 1 + i];
        u32x2 w; w.x = cvtpk(d[0], d[1]); w.y = cvtpk(d[2], d[3]); *(u32x2*)(DP + (size_t)r * DM + c) = w; tot -= v[i]; }
}

__device__ __forceinline__ float gelu_tanh(float x) {
    const float z = 0.7978845608028654f * (x + 0.044715f * x * x * x);
    const float t = __builtin_amdgcn_exp2f(2.885390081777927f * z);
    const float th = 1.f - 2.f * __builtin_amdgcn_rcpf(t + 1.f);
    return 0.5f * x * (1.f + th);
}


#define XB_TMO      128
#define XB_XCNT(j)  (256  + 64 * (j))
#define XB_XSUB(j)  (1280 + 64 * (j))
#define XB_XGEN(j)  (2304 + 64 * (j))
#define XB_TOP      3328
#define XB_TOPGEN   3392
#define XCD_BAR_WORDS 3456
#define XB_SPIN_CAP (1u << 18)
__device__ __forceinline__ unsigned xb_ld(unsigned* p)              { return __hip_atomic_load(p, __ATOMIC_RELAXED, __HIP_MEMORY_SCOPE_AGENT); }
__device__ __forceinline__ unsigned xb_add(unsigned* p, unsigned v) { return __hip_atomic_fetch_add(p, v, __ATOMIC_RELAXED, __HIP_MEMORY_SCOPE_AGENT); }
__device__ __forceinline__ unsigned xb_xcc_id() { return (unsigned)__builtin_amdgcn_s_getreg((3 << 11) | 20) & 0xFu; }
#define XB_SPIN(cond, bar) do { unsigned _sp = 0; while (cond) { __builtin_amdgcn_s_sleep(1); \
    if ((++_sp & 255u) == 0u) { if (xb_ld(&(bar)[XB_TMO])) break; if (_sp > XB_SPIN_CAP) { atomicAdd(&(bar)[XB_TMO], 1u); break; } } } } while (0)
struct XcdBarrier { unsigned* bar; unsigned x; volatile LAS unsigned* st; };
__device__ __forceinline__ void xcd_barrier_complete(unsigned* bar, unsigned x, unsigned& nloc, unsigned& nx) {
    const unsigned G = gridDim.x * gridDim.y * gridDim.z;
    unsigned sum, cnt, mine, sp = 0u;
    for (;;) {
        sum = 0u; cnt = 0u; mine = 0u;
#pragma unroll
        for (unsigned j = 0; j < 16; ++j) { const unsigned c = xb_ld(&bar[XB_XCNT(j)]); sum += c; cnt += (c > 0u) ? 1u : 0u; mine = (j == x) ? c : mine; }
        if (sum == G) break;
        __builtin_amdgcn_s_sleep(1);
        if ((++sp & 255u) == 0u) { if (xb_ld(&bar[XB_TMO])) break; if (sp > XB_SPIN_CAP) { atomicAdd(&bar[XB_TMO], 1u); break; } }
    }
    nloc = mine > 0u ? mine : 1u; nx = cnt > 0u ? cnt : 1u;
}
__device__ __forceinline__ void xcd_barrier(const XcdBarrier& b, bool t0) {
    asm volatile("s_waitcnt vmcnt(0)" ::: "memory");
    __syncthreads();
    if (t0) {
        unsigned* bar = b.bar;
        __builtin_amdgcn_s_waitcnt(0);
        unsigned nloc = b.st[0], nx = b.st[1];
        if (nloc == 0u) { xcd_barrier_complete(bar, b.x, nloc, nx); b.st[0] = nloc; b.st[1] = nx; }
        const unsigned old = xb_add(&bar[XB_XSUB(b.x)], 1u);
        const unsigned gen = old / nloc;
        if (old + 1u == (gen + 1u) * nloc) {
            __builtin_amdgcn_fence(__ATOMIC_RELEASE, "agent");
            asm volatile("s_waitcnt vmcnt(0)" ::: "memory");
            const unsigned og = xb_add(&bar[XB_TOP], 1u);
            const unsigned tg = og / nx;
            if (og + 1u == (tg + 1u) * nx) xb_add(&bar[XB_TOPGEN], 1u);
            else XB_SPIN(xb_ld(&bar[XB_TOPGEN]) == tg, bar);
            __builtin_amdgcn_fence(__ATOMIC_ACQUIRE, "agent");
            xb_add(&bar[XB_XGEN(b.x)], 1u);
            asm volatile("s_waitcnt vmcnt(0)" ::: "memory");
        } else {
            XB_SPIN(xb_ld(&bar[XB_XGEN(b.x)]) == gen, bar);
            __builtin_amdgcn_fence(__ATOMIC_ACQUIRE, "agent");
            asm volatile("s_waitcnt vmcnt(0)" ::: "memory");
        }
    }
    __syncthreads();
}

struct Args { const float* in[22]; float* out; unsigned char* ws; };

__global__ void __launch_bounds__(512, 2) mega_fwd(Args a) {
    extern __shared__ __attribute__((aligned(16))) unsigned char lds_raw[];
    LAS unsigned char* lds = (LAS unsigned char*)lds_raw;
    cg::grid_group grid = cg::this_grid();
    const int wave = __builtin_amdgcn_readfirstlane(threadIdx.x >> 6), G = gridDim.x, bx = blockIdx.x;
    const int gw = bx * 8 + wave, NGW = G * 8;
    const size_t NGT = (size_t)G * 512;
    volatile LAS unsigned* MISC = (volatile LAS unsigned*)(lds + LDS_BYTES - 64);
    if (threadIdx.x < 16) MISC[threadIdx.x] = 0u;
    __syncthreads();
    XcdBarrier xbar; xbar.bar = (unsigned*)(a.ws + WS_CTL); xbar.x = xb_xcc_id(); xbar.st = MISC;
    if (threadIdx.x == 0) (void)xb_add(&xbar.bar[XB_XCNT(xbar.x)], 1u);
    if (G == 0x7fffffff) grid.sync();
#define GRID_SYNC() xcd_barrier(xbar, wave == 0 && lane_fresh() == 0)
#define FRESH_IDS const int lane = lane_fresh(); const int tid = wave * 64 + lane; const size_t gt = (size_t)bx * 512 + tid; (void)gt; (void)tid;
    unsigned char* ws = a.ws; float* out = a.out;
    const float* x_p = a.in[0]; const float* x_s = a.in[1]; const float* cache_k = a.in[2]; const float* cache_v = a.in[3]; const float* st_pool = a.in[4]; const float* st_conv = a.in[5];
    const float* w_in = a.in[6]; const float* sinks = a.in[7]; const float* w_mix = a.in[8]; const float* pool_scale = a.in[9]; const float* w_ab = a.in[10]; const float* w_pb = a.in[11];
    const float* w_out = a.in[12]; const float* ln1g = a.in[13]; const float* ln1b = a.in[14]; const float* w_up = a.in[15]; const float* w_gate = a.in[16]; const float* conv_w = a.in[17];
    const float* conv_b = a.in[18]; const float* w_down = a.in[19]; const float* ln2g = a.in[20]; const float* ln2b = a.in[21];
    bf16_t* WguT = (bf16_t*)(ws + WS_WGU); bf16_t* WdT = (bf16_t*)(ws + WS_WD); bf16_t* R1 = (bf16_t*)(ws + WS_R1);
    bf16_t* WinT = (bf16_t*)(ws + WS_WIN); bf16_t* WabT = (bf16_t*)(ws + WS_WAB); bf16_t* WpbT = (bf16_t*)(ws + WS_WPB); bf16_t* WmixT = (bf16_t*)(ws + WS_WMIX); bf16_t* WoT = (bf16_t*)(ws + WS_WO);
    bf16_t* R2 = (bf16_t*)(ws + WS_R2); float* U = (float*)(ws + WS_U); unsigned short* SG = (unsigned short*)(ws + WS_SG); float* H1 = (float*)(ws + WS_SG);
    bf16_t* Kb = (bf16_t*)(ws + WS_KB); bf16_t* Vb = (bf16_t*)(ws + WS_VB); bf16_t* DP = (bf16_t*)(ws + WS_DP); bf16_t* PY = (bf16_t*)(ws + WS_PY);
    float* COS = (float*)(ws + WS_COS); float* SIN = (float*)(ws + WS_SIN); bf16_t* GU = (bf16_t*)(ws + WS_GU); bf16_t* UB = GU + (size_t)MP * FF;
    const ConvPtrs CP{w_in, w_mix, w_ab, w_pb, w_out, w_gate, w_up, w_down, WinT, WmixT, WabT, WpbT, WoT, WguT, WdT};
    float* Y = out + O_Y;

    {
        FRESH_IDS
        LAS float* scr = (LAS float*)(lds + wave * 16640);
        convert_range(CP, 0, CI_EARLY, gw, NGW, scr, lane);
        for (size_t i0 = gt; i0 < (size_t)MP * DM / 8; i0 += 4 * NGT) {
            f32x4 a0[4], a1[4];
#pragma unroll
            for (int u = 0; u < 4; ++u) { const size_t e = (i0 + u * NGT) * 8; const int r = (int)(e / DM), c = (int)(e % DM); a0[u] = (f32x4){0.f, 0.f, 0.f, 0.f}; a1[u] = a0[u];
                if (r < MR) { const float* src = r < SEQ ? x_p + (size_t)r * DM + c : x_s + (size_t)(r - SEQ) * DM + c; a0[u] = __builtin_nontemporal_load((const f32x4*)src); a1[u] = __builtin_nontemporal_load((const f32x4*)(src + 4)); } }
#pragma unroll
            for (int u = 0; u < 4; ++u) { const size_t e = (i0 + u * NGT) * 8; if (e < (size_t)MP * DM) { u32x4 w; w.x = cvtpk(a0[u][0], a0[u][1]); w.y = cvtpk(a0[u][2], a0[u][3]); w.z = cvtpk(a1[u][0], a1[u][1]); w.w = cvtpk(a1[u][2], a1[u][3]);
                *(u32x4*)(R1 + e) = w; } }
        }
        for (size_t i = gt; i < (size_t)4 * 256 * 256 / 8; i += NGT) { const size_t e = i * 8; const int g = (int)(e >> 16), d = (int)(e & 255);
            const f32x4 a0 = *(const f32x4*)(w_mix + e), a1 = *(const f32x4*)(w_mix + e + 4), s0 = *(const f32x4*)(pool_scale + 256 * g + d), s1 = *(const f32x4*)(pool_scale + 256 * g + d + 4);
            const f32x4 p0 = a0 * s0, p1 = a1 * s1; u32x4 w; w.x = cvtpk(p0[0], p0[1]); w.y = cvtpk(p0[2], p0[3]); w.z = cvtpk(p1[0], p1[1]); w.w = cvtpk(p1[2], p1[3]); *(u32x4*)(WmixT + e) = w; }
        for (size_t i = gt; i < (size_t)(SEQ + 1) * 32; i += NGT) { const int pos = (int)(i >> 5), j = (int)(i & 31);
            const double inv = exp2(-(double)j * (13.287712379549449 / 32.0)); const double ang = (double)pos * inv; COS[i] = (float)cos(ang); SIN[i] = (float)sin(ang); }
    }
    GRID_SYNC();

    {
        if ((bx & 1) == 0) { FRESH_IDS convert_range(CP, CI_EARLY, G == 256 ? CI_ALL - CI_D : CI_ALL, gw, NGW, (LAS float*)(lds + wave * 16640), lane);
        const size_t gt2 = (size_t)(bx >> 1) * 512 + tid, NGT2 = (size_t)((G + 1) >> 1) * 512; (void)gt2;
        for (size_t i0 = gt2; i0 < (size_t)NSMP * 127 * 64; i0 += 4 * NGT2) {
            f32x4 kk[4], vv[4];
#pragma unroll
            for (int u = 0; u < 4; ++u) { const size_t i = i0 + u * NGT2; if (i < (size_t)NSMP * 127 * 64) { const size_t b = i / (127 * 64), rem = i % (127 * 64); const size_t so = (b * 128 + 1) * 256 + rem * 4;
                kk[u] = __builtin_nontemporal_load((const f32x4*)(cache_k + so)); } }
#pragma unroll
            for (int u = 0; u < 4; ++u) { const size_t i = i0 + u * NGT2; if (i < (size_t)NSMP * 127 * 64) { const size_t b = i / (127 * 64), rem = i % (127 * 64); const size_t dof = b * 128 * 256 + rem * 4;
                *(f32x4*)(out + O_KS + dof) = kk[u]; } }
        }
        for (size_t i = gt2; i < (size_t)NSMP * 14 * 256; i += NGT2) { const size_t b = i / (14 * 256), rem = i % (14 * 256);
            *(f32x4*)(out + O_PS + b * 15 * PW + rem * 4) = *(const f32x4*)(st_pool + (b * 15 + 1) * PW + rem * 4); }
            __syncthreads(); }
        { pg8::Gemm g{R1, WinT, DM, DM, DM, 0}; pg8::StaticOrder S; S.init(MP, IND, G, bx);
          EpiIn E{R2, Kb, Vb, U, SG, COS, SIN, out};
          pg8::gemm_phase<EpiIn>(lds, g, S, E, wave); }
        { const int first = (G == 256) ? 222 : 0;
          if (bx >= first && bx < first + 32) { pg8::Gemm g{WpbT, WmixT, 256, PW, 256, 256}; pg8::StaticOrder S; S.init(DM, PW, 32, bx - first); EpiWeff E{PY}; pg8::gemm_phase<EpiWeff>(lds, g, S, E, wave); } }
        if ((bx & 1) != 0) { FRESH_IDS convert_range(CP, CI_EARLY, G == 256 ? CI_ALL - CI_D : CI_ALL, gw, NGW, (LAS float*)(lds + wave * 16640), lane);
        const size_t gt2 = (size_t)(bx >> 1) * 512 + tid, NGT2 = (size_t)((G + 1) >> 1) * 512; (void)gt2;
        for (size_t i0 = gt2; i0 < (size_t)NSMP * 127 * 64; i0 += 4 * NGT2) {
            f32x4 kk[4], vv[4];
#pragma unroll
            for (int u = 0; u < 4; ++u) { const size_t i = i0 + u * NGT2; if (i < (size_t)NSMP * 127 * 64) { const size_t b = i / (127 * 64), rem = i % (127 * 64); const size_t so = (b * 128 + 1) * 256 + rem * 4;
                 vv[u] = __builtin_nontemporal_load((const f32x4*)(cache_v + so)); } }
#pragma unroll
            for (int u = 0; u < 4; ++u) { const size_t i = i0 + u * NGT2; if (i < (size_t)NSMP * 127 * 64) { const size_t b = i / (127 * 64), rem = i % (127 * 64); const size_t dof = b * 128 * 256 + rem * 4;
                 *(f32x4*)(out + O_VS + dof) = vv[u]; } }
        }
        for (size_t i = gt2; i < (size_t)NSMP * (FF / 4); i += NGT2) { const size_t b = i / (FF / 4), rem = i % (FF / 4);
            *(f32x4*)(out + O_CS + b * 2 * FF + rem * 4) = *(const f32x4*)(st_conv + (b * 2 + 1) * FF + rem * 4); }
        }
    }
    GRID_SYNC();

    {
        FRESH_IDS
        bf16_t* AO = R1;
        for (int id = bx; id < 1024; id += G) attn_prompt_unit(lds, tid, id & 3, id >> 2, R2, Kb, Vb, AO, sinks);
        for (int id = bx; id < 512; id += G) attn_sample_unit(lds, tid, id >> 2, id & 3, R2, out + O_KS, out + O_VS, AO, sinks);
        const size_t NPI = (size_t)(SEQ / 16) * 256, NSI = (size_t)NSMP * 256;
        for (size_t it = gt; it < NPI + NSI; it += NGT) {
            if (it < NPI) {
                const int rb = (int)(it >> 8), c = (int)(it & 255) * 4, g = c >> 8, r0 = rb * 16;
                if (g == 0) pool_item<2>(U, DP, r0, c); else if (g == 1) pool_item<4>(U, DP, r0, c); else if (g == 2) pool_item<8>(U, DP, r0, c); else pool_item<16>(U, DP, r0, c);
            } else {
                const size_t k = it - NPI; const int b = (int)(k >> 8), c = (int)(k & 255) * 4, wdw = 2 << (c >> 8), r = SEQ + b;
                const f32x4 cur = *(const f32x4*)(U + (size_t)r * PW + c); f32x4 tot = cur;
                for (int j = 1; j < wdw; ++j) tot += *(const f32x4*)(st_pool + ((size_t)b * 15 + (15 - j)) * PW + c);
                const f32x4 d = tot * (1.f / (float)wdw) - cur;
                u32x2 w; w.x = cvtpk(d[0], d[1]); w.y = cvtpk(d[2], d[3]); *(u32x2*)(DP + (size_t)r * DM + c) = w;
            }
        }
    }
    GRID_SYNC();

    {
        { pg8::Gemm g0{DP, PY  , PW, DM, DM, 0}; pg8::Gemm g1{R1  , WabT, DM, DM, DM, 0}; pg8::StaticOrder S; S.init(SEQ, DM, G, bx); EpiBr E{SG, R2}; pg8::gemm_phase2<EpiBr>(lds, g0, g1, S, E, wave); }
        { FRESH_IDS
          for (int id = bx; id < 256; id += G) { const int r0 = SEQ + 32 * (id & 3), c0 = 32 * (id >> 2);
              const f32x2 va = thin_unit(lds, wave, lane, DP + (size_t)r0 * DM, DM, PY + (size_t)c0 * DM, DM, PW);
              const f32x2 vb = thin_unit(lds, wave, lane, R1 + (size_t)r0 * DM, DM, WabT + (size_t)c0 * DM, DM, DM);
              const int r = r0 + (tid >> 4), c = c0 + 2 * (tid & 15);
              const unsigned gp = *(const unsigned*)(SG + (size_t)r * 4096 + c), ga = *(const unsigned*)(SG + (size_t)r * 4096 + 2048 + c);
              *(unsigned*)(R2 + (size_t)r * DM + c) = cvtpk(hlo(gp) * va[0] + hlo(ga) * vb[0], hhi(gp) * va[1] + hhi(ga) * vb[1]); } }
    }
    GRID_SYNC();

    {
        unsigned* ctl = (unsigned*)(ws + WS_CTL); float* rs1 = (float*)(ctl + CW_RS1);
        if (G == 256) { pg8::Gemm g{R2, WoT, DM, DM, DM, 0}; pg8::StaticOrder S; S.init(SEQ, DM, G, bx); EpiOutLN E{x_p, Y, R1, lds + 131072, rs1, ctl + CW_CNT, ln1g, ln1b}; pg8::gemm_phase<EpiOutLN>(lds, g, S, E, wave); }
        { FRESH_IDS
          if (G == 256) { const int id = bx; const int r0 = SEQ + 32 * (id & 3), c0 = 32 * (id >> 2);
              const f32x2 v = thin_unit(lds, wave, lane, R2 + (size_t)r0 * DM, DM, WoT + (size_t)c0 * DM, DM, DM);
              const int r = r0 + (tid >> 4), c = c0 + 2 * (tid & 15);
              const f32x2 xv = *(const f32x2*)(x_s + (size_t)(r - SEQ) * DM + c);
              const f32x2 z = ln_thin(xv * ALPHA + v, r, tid, (float*)(ctl + CW_TS1), ctl + CW_CNT + 2048 + 64 * (id & 3));
              const f32x2 o = z * *(const f32x2*)(ln1g + c) + *(const f32x2*)(ln1b + c);
              *(f32x2*)(Y + (size_t)r * DM + c) = o; *(unsigned*)(R1 + (size_t)r * DM + c) = cvtpk(o[0], o[1]); } }
    }
    GRID_SYNC();

    {
        pg8::Gemm g{R1, WguT, DM, DM, DM, 0}; pg8::StaticOrder S; S.init(MP, 2 * FF, G, bx, 3); EpiGU E{GU, out}; pg8::gemm_phase<EpiGU>(lds, g, S, E, wave);
        if (G == 256 && bx >= 172) { FRESH_IDS convert_range(CP, CI_ALL - CI_D, CI_ALL, gw - 172 * 8, 84 * 8, (LAS float*)(lds + wave * 16640), lane); }
    }
    GRID_SYNC();

    { FRESH_IDS
      const size_t NPI = (size_t)(SEQ / 8) * (FF / 8), NSI = (size_t)NSMP * (FF / 8);
      for (size_t it = gt; it < NPI + NSI; it += NGT) {
          const bool smp = it >= NPI; const size_t k = smp ? it - NPI : it;
          const int rb = (int)(k / (FF / 8)), c = (int)(k % (FF / 8)) * 8;
          f32x4 cw[3][2], cb[2];
#pragma unroll
          for (int h = 0; h < 2; ++h) { cb[h] = *(const f32x4*)(conv_b + c + 4 * h);
#pragma unroll
              for (int j = 0; j < 3; ++j) cw[j][h] = *(const f32x4*)(conv_w + (size_t)j * FF + c + 4 * h); }
          if (!smp) {
              const int r0 = rb * 8; u32x4 gw_[10], uw[8];
#pragma unroll
              for (int i = 0; i < 10; ++i) { const int r = r0 - 2 + i; gw_[i] = r >= 0 ? *(const u32x4*)(GU + (size_t)r * FF + c) : (u32x4){0u, 0u, 0u, 0u}; }
#pragma unroll
              for (int i = 0; i < 8; ++i) uw[i] = *(const u32x4*)(UB + (size_t)(r0 + i) * FF + c);
#pragma unroll
              for (int i = 0; i < 8; ++i) { u32x4 wo;
#pragma unroll
                  for (int h = 0; h < 2; ++h) {
                      const f32x4 g0 = {bflo(gw_[i][2 * h]), bfhi(gw_[i][2 * h]), bflo(gw_[i][2 * h + 1]), bfhi(gw_[i][2 * h + 1])};
                      const f32x4 g1 = {bflo(gw_[i + 1][2 * h]), bfhi(gw_[i + 1][2 * h]), bflo(gw_[i + 1][2 * h + 1]), bfhi(gw_[i + 1][2 * h + 1])};
                      const f32x4 g2 = {bflo(gw_[i + 2][2 * h]), bfhi(gw_[i + 2][2 * h]), bflo(gw_[i + 2][2 * h + 1]), bfhi(gw_[i + 2][2 * h + 1])};
                      const f32x4 up = {bflo(uw[i][2 * h]), bfhi(uw[i][2 * h]), bflo(uw[i][2 * h + 1]), bfhi(uw[i][2 * h + 1])};
                      const f32x4 y = cb[h] + cw[0][h] * g0 + cw[1][h] * g1 + cw[2][h] * g2;
                      const f32x4 hv = {gelu_tanh(y[0]) * up[0], gelu_tanh(y[1]) * up[1], gelu_tanh(y[2]) * up[2], gelu_tanh(y[3]) * up[3]};
                      wo[2 * h] = cvtpk(hv[0], hv[1]); wo[2 * h + 1] = cvtpk(hv[2], hv[3]); }
                  *(u32x4*)(UB + (size_t)(r0 + i) * FF + c) = wo; }
          } else {
              const int r = SEQ + rb; const float* h0 = st_conv + (size_t)rb * 2 * FF + c;
              const u32x4 gwv = *(const u32x4*)(GU + (size_t)r * FF + c), uwv = *(const u32x4*)(UB + (size_t)r * FF + c); u32x4 wo;
#pragma unroll
              for (int h = 0; h < 2; ++h) {
                  const f32x4 g0 = *(const f32x4*)(h0 + 4 * h), g1 = *(const f32x4*)(h0 + FF + 4 * h);
                  const f32x4 g2 = {bflo(gwv[2 * h]), bfhi(gwv[2 * h]), bflo(gwv[2 * h + 1]), bfhi(gwv[2 * h + 1])};
                  const f32x4 up = {bflo(uwv[2 * h]), bfhi(uwv[2 * h]), bflo(uwv[2 * h + 1]), bfhi(uwv[2 * h + 1])};
                  const f32x4 y = cb[h] + cw[0][h] * g0 + cw[1][h] * g1 + cw[2][h] * g2;
                  const f32x4 hv = {gelu_tanh(y[0]) * up[0], gelu_tanh(y[1]) * up[1], gelu_tanh(y[2]) * up[2], gelu_tanh(y[3]) * up[3]};
                  wo[2 * h] = cvtpk(hv[0], hv[1]); wo[2 * h + 1] = cvtpk(hv[2], hv[3]); }
              *(u32x4*)(UB + (size_t)r * FF + c) = wo;
          }
      } }
    GRID_SYNC();

    {
        unsigned* ctl = (unsigned*)(ws + WS_CTL); float* rs2 = (float*)(ctl + CW_RS2);
        if (G == 256) { pg8::Gemm g{UB, WdT, FF, FF, FF, 0}; pg8::StaticOrder S; S.init(SEQ, DM, G, bx); EpiDownLN E{Y, R1, lds + 131072, rs2, ctl + CW_CNT + 4096, ln2g, ln2b}; pg8::gemm_phase<EpiDownLN>(lds, g, S, E, wave); }
        { FRESH_IDS
          if (G == 256) { const int id = bx; const int r0 = SEQ + 32 * (id & 3), c0 = 32 * (id >> 2);
              const f32x2 v = thin_unit(lds, wave, lane, UB + (size_t)r0 * FF, FF, WdT + (size_t)c0 * FF, FF, FF);
              const int r = r0 + (tid >> 4), c = c0 + 2 * (tid & 15);
              float* yp = Y + (size_t)r * DM + c;
              const f32x2 z = ln_thin(*(const f32x2*)yp * ALPHA + v, r, tid, (float*)(ctl + CW_TS2), ctl + CW_CNT + 6144 + 64 * (id & 3));
              *(f32x2*)yp = z * *(const f32x2*)(ln2g + c) + *(const f32x2*)(ln2b + c); } }
    }
}

extern "C" void kernel_launch(void* const* d_in, const int* in_sizes, int n_in, void* d_out, int out_size, void* d_ws, size_t ws_size, hipStream_t stream) {
    static int grid = 0;
    if (grid == 0) {
        if (n_in != 22 || ws_size < WS_TOTAL) { fprintf(stderr, "kernel_launch: need 22 inputs and >= %zu bytes of workspace (got %d, %zu)\n", (size_t)WS_TOTAL, n_in, ws_size); grid = -1; return; }
        int dev = 0, cus = 0, per_cu = 0;
        (void)hipGetDevice(&dev); (void)hipDeviceGetAttribute(&cus, hipDeviceAttributeMultiprocessorCount, dev);
        (void)hipFuncSetAttribute((const void*)mega_fwd, hipFuncAttributeMaxDynamicSharedMemorySize, LDS_BYTES);
        if (hipOccupancyMaxActiveBlocksPerMultiprocessor(&per_cu, (const void*)mega_fwd, 512, LDS_BYTES) != hipSuccess || per_cu < 1) { fprintf(stderr, "kernel_launch: occupancy query says %d blocks per CU\n", per_cu); per_cu = 1; }
        (void)hipGetLastError();
        grid = cus;
    }
    if (grid < 0) return;
    (void)hipMemsetAsync((char*)d_ws + WS_CTL, 0, CTL_BYTES, stream);
    Args a{};
    for (int i = 0; i < 22; ++i) a.in[i] = (const float*)d_in[i];
    a.out = (float*)d_out; a.ws = (unsigned char*)d_ws;
    void* args[] = {&a};
    hipError_t e = hipLaunchCooperativeKernel((const void*)mega_fwd, dim3(grid), dim3(512), args, LDS_BYTES, stream);
    if (e != hipSuccess) fprintf(stderr, "cooperative launch failed: %s (grid %d)\n", hipGetErrorString(e), grid);
}
```

```cpp
#include <hip/hip_runtime.h>
#include <hip/hip_cooperative_groups.h>
#include <cstdio>
#include <cstdint>
namespace cg = cooperative_groups;

#define LAS __attribute__((address_space(3)))
typedef unsigned short bf16_t;
typedef short bf16x8 __attribute__((ext_vector_type(8)));
typedef float f32x4 __attribute__((ext_vector_type(4)));
typedef float f32x2 __attribute__((ext_vector_type(2)));
typedef float f32x16 __attribute__((ext_vector_type(16)));
typedef unsigned u32x4 __attribute__((ext_vector_type(4)));
typedef unsigned u32x2 __attribute__((ext_vector_type(2)));
typedef __bf16 bf16x2_t __attribute__((ext_vector_type(2)));
typedef _Float16 h2_t __attribute__((ext_vector_type(2)));

constexpr int DM = 2048, SEQ = 8192, NSMP = 128, MR = SEQ + NSMP  , MP = 8448  ;
constexpr int KVD = 256, PW = 1024, FF = 5632, IND = 7680, NH = 32, HD = 64;
constexpr float LN_EPS = 1e-5f;
constexpr float LOG2E = 1.4426950408889634f;
constexpr float QSCALE = 0.125f * LOG2E;
constexpr float ALPHA = 1.189207115002721f;

constexpr size_t O_Y = 0, O_KP = 17039360, O_VP = 17072128, O_PP = 17104896, O_CP = 17120256, O_KS = 17131520, O_VS = 21325824, O_PS = 25520128, O_CS = 27486208;

constexpr size_t MiB = 1u << 20;
constexpr size_t WS_WGU = 0, WS_WD = 44 * MiB, WS_R1 = 66 * MiB  , WS_EARLY = 99 * MiB;
constexpr size_t WS_WIN = WS_EARLY, WS_WAB = WS_WIN + 30 * MiB, WS_WPB = WS_WAB + 8 * MiB, WS_WMIX = WS_WPB + 4 * MiB, WS_WO = WS_WMIX + 1 * MiB;
constexpr size_t WS_R2 = WS_WO + 8 * MiB  , WS_U = WS_R2 + 33 * MiB, WS_SG = WS_U + 33 * MiB  , WS_KB = WS_SG + 66 * MiB, WS_VB = WS_KB + 5 * MiB;
constexpr size_t WS_DP = WS_VB + 5 * MiB  , WS_PY = WS_DP + 33 * MiB  , WS_COS = WS_PY + 8 * MiB, WS_SIN = WS_COS + 2 * MiB, WS_END = WS_SIN + 2 * MiB;
constexpr size_t WS_GU = WS_EARLY;
static_assert(WS_END == 337 * MiB, "ws map");
constexpr size_t WS_CTL = WS_END, CTL_BYTES = 262144, WS_TOTAL = WS_CTL + CTL_BYTES;
constexpr int CW_RS1 = 4096, CW_RS2 = 21504, CW_CNT = 38912, CW_TS1 = 49152, CW_TS2 = 53248;
static_assert((CW_TS2 + 4096) * 4 <= (int)CTL_BYTES, "ctl map 2");
constexpr int CW_UNUSED_ = 0;
static_assert((CW_CNT + 6400) * 4 <= (int)CTL_BYTES && CW_RS1 + 2 * 8320 <= CW_RS2 && CW_RS2 + 2 * 8320 <= CW_CNT, "ctl map");
static_assert(WS_GU + (size_t)MP * 2 * FF * 2 <= WS_END, "GU overlay");

constexpr int LDS_BYTES = 147456;

__device__ __forceinline__ int lane_fresh() { int l; asm volatile("v_mbcnt_lo_u32_b32 %0, -1, 0\n\tv_mbcnt_hi_u32_b32 %0, -1, %0" : "=v"(l)); return l; }
__device__ __forceinline__ unsigned cvtpk(float lo, float hi) { f32x2 v = {lo, hi}; bf16x2_t b = __builtin_convertvector(v, bf16x2_t); return __builtin_bit_cast(unsigned, b); }
__device__ __forceinline__ float bf2f(unsigned short h) { return __builtin_bit_cast(float, (unsigned)h << 16); }
__device__ __forceinline__ float bflo(unsigned w) { return __builtin_bit_cast(float, w << 16); }
__device__ __forceinline__ float bfhi(unsigned w) { return __builtin_bit_cast(float, w & 0xffff0000u); }
__device__ __forceinline__ unsigned pkh(float a, float b) { h2_t v = {(_Float16)a, (_Float16)b}; return __builtin_bit_cast(unsigned, v); }
__device__ __forceinline__ float hlo(unsigned w) { h2_t v = __builtin_bit_cast(h2_t, w); return (float)v.x; }
__device__ __forceinline__ float hhi(unsigned w) { h2_t v = __builtin_bit_cast(h2_t, w); return (float)v.y; }
__device__ __forceinline__ float sigmoidf_(float v) { return __builtin_amdgcn_rcpf(1.f + __builtin_amdgcn_exp2f(-1.4426950408889634f * v)); }

namespace pg8 {
constexpr int BM = 256, BK = 64, HALF = 128, HTB = HALF * BK * 2, STAGE_BYTES = 8 * HTB, NXCD = 8, WGM = 8;
__host__ __device__ __forceinline__ int lds_byte(int r, int c) { const int st = (r >> 4) * 2 + (c >> 5), rr = r & 15, cc = c & 31, ob = rr * 64 + cc * 2; return st * 1024 + (ob ^ (((ob >> 9) & 1) << 5)); }
__host__ __device__ __forceinline__ void stage_rc(int b, int& R, int& C) { const int st = b / 1024, sb = b % 1024, swz = sb ^ (((sb >> 9) & 1) << 5); R = (st >> 1) * 16 + swz / 64; C = (st & 1) * 32 + (swz % 64) / 2; }
__host__ __device__ __forceinline__ int perm32(int rho) { const int n = rho >> 4, i = rho & 15; return 8 * (i >> 2) + 4 * n + (i & 3); }
struct Unit { int pm, pn; };
struct Gemm { const bf16_t* A; const bf16_t* Bt; int K, lda, ldb, acol; };
struct StaticOrder {
    int nM, nN, nwg, G, c, wgm;
    __device__ void init(int M, int N, int G_, int c_, int wgm_ = WGM) { nM = M / BM; nN = N / BM; nwg = nM * nN; G = G_; c = c_; wgm = wgm_; }
    __device__ bool next(int i, Unit& u) const {
        const long L = (long)i * G + c; if (L >= nwg) return false;
        int wgid = (int)L; { const int q = nwg / NXCD, r = nwg % NXCD, xcd = wgid % NXCD, off = wgid / NXCD; wgid = (xcd < r ? xcd * (q + 1) : r * (q + 1) + (xcd - r) * q) + off; }
        const int nig = wgm * nN, gid = wgid / nig, fm = gid * wgm, gsz = (nM - fm) < wgm ? (nM - fm) : wgm;
        u.pm = fm + ((wgid % nig) % gsz); u.pn = (wgid % nig) / gsz; return true;
    }
};
template <class Epi>
__device__ __forceinline__ void gemm_phase(LAS unsigned char* lds, const Gemm g, const StaticOrder& S, const Epi& E, int wid) {
    const int lane = lane_fresh(), tid = wid * 64 + lane, wr = wid >> 2, wc = wid & 3, fr = lane & 15, fq = lane >> 4;
    int K = g.K; asm volatile("" : "+s"(K));
    const int nt = K / BK;
    unsigned voffA[2], voffB[2];
#pragma unroll
    for (int i = 0; i < 2; ++i) { int R, C; stage_rc(tid * 16 + i * 8192, R, C); const int Rb = Epi::PERM ? ((R & ~31) + perm32(R & 31)) : R;
        voffA[i] = (unsigned)(R * g.lda + C) * 2u; voffB[i] = (unsigned)(Rb * g.ldb + C) * 2u; }
    const size_t kstep = (size_t)(BK * 2);
    const size_t hsA = (size_t)HALF * g.lda * 2, hsB = (size_t)HALF * g.ldb * 2;
    const unsigned ldsw = (unsigned)wid * 1024u;
    const int aoff = lds_byte(wr * 64 + fr, fq * 8), boff = lds_byte(wc * 32 + fr, fq * 8);
#define PG8_SA(b, h) (((b) * 2 + (h)) * HTB)
#define PG8_SB(b, h) ((4 + (b) * 2 + (h)) * HTB)
#define PG8_STAGE(bufoff, gbase, voff) do { _Pragma("unroll") for (int _i = 0; _i < 2; ++_i) \
        __builtin_amdgcn_global_load_lds((const unsigned*)((const char*)(gbase) + (voff)[_i]), (LAS unsigned*)(lds + (bufoff) + ldsw + _i * 8192), 16, 0, 0); } while (0)
#define PG8_LDA(dst, b, h) do { _Pragma("unroll") for (int m = 0; m < 4; ++m) _Pragma("unroll") for (int k = 0; k < 2; ++k) dst[m][k] = *(const LAS bf16x8*)(lds + PG8_SA(b, h) + aoff + m * 2048 + k * 1024); } while (0)
#define PG8_LDB(dst, b, h) do { _Pragma("unroll") for (int n = 0; n < 2; ++n) _Pragma("unroll") for (int k = 0; k < 2; ++k) dst[n][k] = *(const LAS bf16x8*)(lds + PG8_SB(b, h) + boff + n * 2048 + k * 1024); } while (0)
#define PG8_MMA(ai, bj, At, Bt) do { __builtin_amdgcn_s_setprio(1); _Pragma("unroll") for (int m = 0; m < 4; ++m) _Pragma("unroll") for (int n = 0; n < 2; ++n) _Pragma("unroll") for (int k = 0; k < 2; ++k) \
        acc[ai][bj][m][n] = __builtin_amdgcn_mfma_f32_16x16x32_bf16(Bt[n][k], At[m][k], acc[ai][bj][m][n], 0, 0, 0); __builtin_amdgcn_s_setprio(0); } while (0)
#define PG8_WAIT_V(n) asm volatile("s_waitcnt vmcnt(" #n ")" ::: "memory")
#define PG8_WAIT_L(n) asm volatile("s_waitcnt lgkmcnt(" #n ")" ::: "memory")
#define PG8_BAR __builtin_amdgcn_s_barrier()
#define PG8_SCHED __builtin_amdgcn_sched_barrier(0)
    Unit cur, nxt; int ui = 0;
    if (!S.next(0, cur)) return;
    f32x4 acc[2][2][4][2];
#pragma unroll
    for (int a = 0; a < 2; ++a)
#pragma unroll
        for (int b = 0; b < 2; ++b)
#pragma unroll
            for (int m = 0; m < 4; ++m)
#pragma unroll
                for (int n = 0; n < 2; ++n) acc[a][b][m][n] = (f32x4){0.f, 0.f, 0.f, 0.f};
    bf16x8 At[4][2], B0[2][2], B1[2][2];
    const char* cA = (const char*)g.A + (size_t)cur.pm * 2 * hsA + (size_t)cur.pn * g.acol * 2; const char* cB = (const char*)g.Bt + (size_t)cur.pn * 2 * hsB;
    PG8_STAGE(PG8_SB(0, 0), cB, voffB); PG8_STAGE(PG8_SB(0, 1), cB + hsB, voffB); PG8_STAGE(PG8_SA(0, 0), cA, voffA); PG8_STAGE(PG8_SA(0, 1), cA + hsA, voffA);
    if (wr == 1) PG8_BAR;
    PG8_WAIT_V(2); PG8_BAR;
    PG8_STAGE(PG8_SB(1, 0), cB + kstep, voffB); PG8_STAGE(PG8_SA(1, 0), cA + kstep, voffA); PG8_STAGE(PG8_SB(1, 1), cB + hsB + kstep, voffB);
    PG8_WAIT_V(6); PG8_BAR;
    for (;;) {
        const bool has_next = S.next(ui + 1, nxt);
        const char* nA = has_next ? (const char*)g.A + (size_t)nxt.pm * 2 * hsA + (size_t)nxt.pn * g.acol * 2 : cA; const char* nB = has_next ? (const char*)g.Bt + (size_t)nxt.pn * 2 * hsB : cB;
        for (int t = 0; t < nt; t += 2) {
            const bool last = (t == nt - 2);
            const char* a1 = cA + (size_t)(t + 1) * kstep;
            const char* a2 = last ? nA : cA + (size_t)(t + 2) * kstep; const char* b2 = last ? nB : cB + (size_t)(t + 2) * kstep;
            const char* a3 = a2 + kstep; const char* b3 = b2 + kstep;
            PG8_LDB(B0, 0, 0); PG8_LDB(B1, 0, 1); PG8_SCHED; PG8_LDA(At, 0, 0); PG8_STAGE(PG8_SA(1, 1), a1 + hsA, voffA);
            PG8_WAIT_V(8); PG8_WAIT_L(0); PG8_BAR; PG8_MMA(0, 0, At, B0); PG8_MMA(0, 1, At, B1); PG8_BAR; PG8_SCHED;
            PG8_LDA(At, 0, 1); PG8_STAGE(PG8_SB(0, 0), b2, voffB); PG8_STAGE(PG8_SB(0, 1), b2 + hsB, voffB); PG8_STAGE(PG8_SA(0, 0), a2, voffA);
            PG8_WAIT_V(8); PG8_WAIT_L(0); PG8_BAR; PG8_MMA(1, 0, At, B0); PG8_MMA(1, 1, At, B1); PG8_BAR; PG8_SCHED;
            PG8_LDB(B0, 1, 0); PG8_LDB(B1, 1, 1); PG8_SCHED; PG8_LDA(At, 1, 0); PG8_STAGE(PG8_SA(0, 1), a2 + hsA, voffA);
            PG8_WAIT_V(8); PG8_WAIT_L(0); PG8_BAR; PG8_MMA(0, 0, At, B0); PG8_MMA(0, 1, At, B1); PG8_BAR; PG8_SCHED;
            PG8_LDA(At, 1, 1); PG8_STAGE(PG8_SB(1, 0), b3, voffB); PG8_STAGE(PG8_SB(1, 1), b3 + hsB, voffB); PG8_STAGE(PG8_SA(1, 0), a3, voffA);
            PG8_WAIT_V(8); PG8_WAIT_L(0); PG8_BAR; PG8_MMA(1, 0, At, B0); PG8_MMA(1, 1, At, B1); PG8_BAR; PG8_SCHED;
        }
        if (wr == 0) PG8_BAR;
        E(acc, cur, wr, wc, fr, fq);
        if (!has_next) break;
#pragma unroll
        for (int a = 0; a < 2; ++a)
#pragma unroll
            for (int b = 0; b < 2; ++b)
#pragma unroll
                for (int m = 0; m < 4; ++m)
#pragma unroll
                    for (int n = 0; n < 2; ++n) acc[a][b][m][n] = (f32x4){0.f, 0.f, 0.f, 0.f};
        cur = nxt; cA = nA; cB = nB; ++ui;
        if (wr == 1) PG8_BAR;
    }
    PG8_WAIT_V(0);
    PG8_BAR;
#undef PG8_SA
#undef PG8_SB
#undef PG8_STAGE
#undef PG8_LDA
#undef PG8_LDB
#undef PG8_MMA
#undef PG8_WAIT_V
#undef PG8_WAIT_L
#undef PG8_BAR
#undef PG8_SCHED
}
template <class Epi>
__device__ __forceinline__ void gemm_phase2(LAS unsigned char* lds, const Gemm g, const Gemm g1, const StaticOrder& S, const Epi& E, int wid) {
    const int lane = lane_fresh(), tid = wid * 64 + lane, wr = wid >> 2, wc = wid & 3, fr = lane & 15, fq = lane >> 4;
    int K0 = g.K, K1 = g1.K; asm volatile("" : "+s"(K0), "+s"(K1));
    const int nt0 = K0 / BK, nt1 = K1 / BK;
    unsigned voffA[2], voffB[2];
#pragma unroll
    for (int i = 0; i < 2; ++i) { int R, C; stage_rc(tid * 16 + i * 8192, R, C); const int Rb = Epi::PERM ? ((R & ~31) + perm32(R & 31)) : R;
        voffA[i] = (unsigned)(R * g.lda + C) * 2u; voffB[i] = (unsigned)(Rb * g.ldb + C) * 2u; }
    const size_t kstep = (size_t)(BK * 2);
    const size_t hsA = (size_t)HALF * g.lda * 2, hsB = (size_t)HALF * g.ldb * 2;
    const unsigned ldsw = (unsigned)wid * 1024u;
    const int aoff = lds_byte(wr * 64 + fr, fq * 8), boff = lds_byte(wc * 32 + fr, fq * 8);
#define PG8_SA(b, h) (((b) * 2 + (h)) * HTB)
#define PG8_SB(b, h) ((4 + (b) * 2 + (h)) * HTB)
#define PG8_STAGE(bufoff, gbase, voff) do { _Pragma("unroll") for (int _i = 0; _i < 2; ++_i) \
        __builtin_amdgcn_global_load_lds((const unsigned*)((const char*)(gbase) + (voff)[_i]), (LAS unsigned*)(lds + (bufoff) + ldsw + _i * 8192), 16, 0, 0); } while (0)
#define PG8_LDA(dst, b, h) do { _Pragma("unroll") for (int m = 0; m < 4; ++m) _Pragma("unroll") for (int k = 0; k < 2; ++k) dst[m][k] = *(const LAS bf16x8*)(lds + PG8_SA(b, h) + aoff + m * 2048 + k * 1024); } while (0)
#define PG8_LDB(dst, b, h) do { _Pragma("unroll") for (int n = 0; n < 2; ++n) _Pragma("unroll") for (int k = 0; k < 2; ++k) dst[n][k] = *(const LAS bf16x8*)(lds + PG8_SB(b, h) + boff + n * 2048 + k * 1024); } while (0)
#define PG8_MMA(ai, bj, At, Bt) do { __builtin_amdgcn_s_setprio(1); _Pragma("unroll") for (int m = 0; m < 4; ++m) _Pragma("unroll") for (int n = 0; n < 2; ++n) _Pragma("unroll") for (int k = 0; k < 2; ++k) \
        acc[ai][bj][m][n] = __builtin_amdgcn_mfma_f32_16x16x32_bf16(Bt[n][k], At[m][k], acc[ai][bj][m][n], 0, 0, 0); __builtin_amdgcn_s_setprio(0); } while (0)
#define PG8_WAIT_V(n) asm volatile("s_waitcnt vmcnt(" #n ")" ::: "memory")
#define PG8_WAIT_L(n) asm volatile("s_waitcnt lgkmcnt(" #n ")" ::: "memory")
#define PG8_BAR __builtin_amdgcn_s_barrier()
#define PG8_SCHED __builtin_amdgcn_sched_barrier(0)
    Unit cur, nxt; int ui = 0;
    if (!S.next(0, cur)) return;
#define SEG_A(u_, sg_) ((const char*)((sg_) ? g1.A : g.A) + (size_t)(u_).pm * 2 * hsA)
#define SEG_B(u_, sg_) ((const char*)((sg_) ? g1.Bt : g.Bt) + (size_t)(u_).pn * 2 * hsB)
    f32x4 acc[2][2][4][2];
#pragma unroll
    for (int a = 0; a < 2; ++a)
#pragma unroll
        for (int b = 0; b < 2; ++b)
#pragma unroll
            for (int m = 0; m < 4; ++m)
#pragma unroll
                for (int n = 0; n < 2; ++n) acc[a][b][m][n] = (f32x4){0.f, 0.f, 0.f, 0.f};
    bf16x8 At[4][2], B0[2][2], B1[2][2];
    const char* cA = SEG_A(cur, 0); const char* cB = SEG_B(cur, 0);
    PG8_STAGE(PG8_SB(0, 0), cB, voffB); PG8_STAGE(PG8_SB(0, 1), cB + hsB, voffB); PG8_STAGE(PG8_SA(0, 0), cA, voffA); PG8_STAGE(PG8_SA(0, 1), cA + hsA, voffA);
    if (wr == 1) PG8_BAR;
    PG8_WAIT_V(2); PG8_BAR;
    PG8_STAGE(PG8_SB(1, 0), cB + kstep, voffB); PG8_STAGE(PG8_SA(1, 0), cA + kstep, voffA); PG8_STAGE(PG8_SB(1, 1), cB + hsB + kstep, voffB);
    PG8_WAIT_V(6); PG8_BAR;
    for (;;) {
        const int seg = ui & 1, nt = seg ? nt1 : nt0;
        bool has_next = true; nxt = cur; if (seg) has_next = S.next((ui + 1) >> 1, nxt);
        const char* nA = has_next ? SEG_A(nxt, seg ^ 1) : cA; const char* nB = has_next ? SEG_B(nxt, seg ^ 1) : cB;
        for (int t = 0; t < nt; t += 2) {
            const bool last = (t == nt - 2);
            const char* a1 = cA + (size_t)(t + 1) * kstep;
            const char* a2 = last ? nA : cA + (size_t)(t + 2) * kstep; const char* b2 = last ? nB : cB + (size_t)(t + 2) * kstep;
            const char* a3 = a2 + kstep; const char* b3 = b2 + kstep;
            PG8_LDB(B0, 0, 0); PG8_LDB(B1, 0, 1); PG8_SCHED; PG8_LDA(At, 0, 0); PG8_STAGE(PG8_SA(1, 1), a1 + hsA, voffA);
            PG8_WAIT_V(8); PG8_WAIT_L(0); PG8_BAR; PG8_MMA(0, 0, At, B0); PG8_MMA(0, 1, At, B1); PG8_BAR; PG8_SCHED;
            PG8_LDA(At, 0, 1); PG8_STAGE(PG8_SB(0, 0), b2, voffB); PG8_STAGE(PG8_SB(0, 1), b2 + hsB, voffB); PG8_STAGE(PG8_SA(0, 0), a2, voffA);
            PG8_WAIT_V(8); PG8_WAIT_L(0); PG8_BAR; PG8_MMA(1, 0, At, B0); PG8_MMA(1, 1, At, B1); PG8_BAR; PG8_SCHED;
            PG8_LDB(B0, 1, 0); PG8_LDB(B1, 1, 1); PG8_SCHED; PG8_LDA(At, 1, 0); PG8_STAGE(PG8_SA(0, 1), a2 + hsA, voffA);
            PG8_WAIT_V(8); PG8_WAIT_L(0); PG8_BAR; PG8_MMA(0, 0, At, B0); PG8_MMA(0, 1, At, B1); PG8_BAR; PG8_SCHED;
            PG8_LDA(At, 1, 1); PG8_STAGE(PG8_SB(1, 0), b3, voffB); PG8_STAGE(PG8_SB(1, 1), b3 + hsB, voffB); PG8_STAGE(PG8_SA(1, 0), a3, voffA);
            PG8_WAIT_V(8); PG8_WAIT_L(0); PG8_BAR; PG8_MMA(1, 0, At, B0); PG8_MMA(1, 1, At, B1); PG8_BAR; PG8_SCHED;
        }
        if (wr == 0) PG8_BAR;
        if (seg == 0) E.mid(acc, cur, wr, wc, fr, fq); else E(acc, cur, wr, wc, fr, fq);
        if (!has_next) break;
        if (seg)
#pragma unroll
        for (int a = 0; a < 2; ++a)
#pragma unroll
            for (int b = 0; b < 2; ++b)
#pragma unroll
                for (int m = 0; m < 4; ++m)
#pragma unroll
                    for (int n = 0; n < 2; ++n) acc[a][b][m][n] = (f32x4){0.f, 0.f, 0.f, 0.f};
        cur = nxt; cA = nA; cB = nB; ++ui;
        if (wr == 1) PG8_BAR;
    }
    PG8_WAIT_V(0);
    PG8_BAR;
#undef SEG_A
#undef SEG_B
#undef PG8_SA
#undef PG8_SB
#undef PG8_STAGE
#undef PG8_LDA
#undef PG8_LDB
#undef PG8_MMA
#undef PG8_WAIT_V
#undef PG8_WAIT_L
#undef PG8_BAR
#undef PG8_SCHED
}
}
using pg8::Unit;

#define ROW_OF(u, ai, wr, m, fr) ((u).pm * 256 + (ai) * 128 + (wr) * 64 + (m) * 16 + (fr))

struct EpiIn {
    static constexpr bool PERM = true;
    bf16_t* Q; bf16_t* Kb; bf16_t* Vb; float* U; unsigned short* SG; const float* COS; const float* SIN; float* out;
    __device__ __forceinline__ void operator()(const f32x4 (&acc)[2][2][4][2], const Unit& u, int wr, int wc, int fr, int fq) const {
        const int pn = u.pn;
        if (pn <= 8) {
            const float sc = pn < 8 ? QSCALE : 1.f;
            bf16_t* dst = pn < 8 ? Q : Kb; const int ld = pn < 8 ? DM : KVD; const int cb = (pn < 8 ? pn * 256 : 0) + 64 * wc + 8 * fq;
#pragma unroll
            for (int ai = 0; ai < 2; ++ai) {
                f32x4 tc0[4], tc1[4], ts0[4], ts1[4];
#pragma unroll
                for (int m = 0; m < 4; ++m) { const int r = ROW_OF(u, ai, wr, m, fr); const int pos = r < SEQ ? r : SEQ;
                    tc0[m] = *(const f32x4*)(COS + pos * 32 + 8 * fq); tc1[m] = *(const f32x4*)(COS + pos * 32 + 8 * fq + 4);
                    ts0[m] = *(const f32x4*)(SIN + pos * 32 + 8 * fq); ts1[m] = *(const f32x4*)(SIN + pos * 32 + 8 * fq + 4); }
#pragma unroll
                for (int m = 0; m < 4; ++m) {
                    const int r = ROW_OF(u, ai, wr, m, fr);
                    const f32x4 c0 = tc0[m], c1 = tc1[m], s0 = ts0[m], s1 = ts1[m];
                    const f32x4 a0 = acc[ai][0][m][0], a1 = acc[ai][0][m][1], b0 = acc[ai][1][m][0], b1 = acc[ai][1][m][1];
                    const f32x4 o10 = (a0 * c0 - b0 * s0) * sc, o11 = (a1 * c1 - b1 * s1) * sc, o20 = (b0 * c0 + a0 * s0) * sc, o21 = (b1 * c1 + a1 * s1) * sc;
                    u32x4 w1, w2; w1.x = cvtpk(o10[0], o10[1]); w1.y = cvtpk(o10[2], o10[3]); w1.z = cvtpk(o11[0], o11[1]); w1.w = cvtpk(o11[2], o11[3]);
                    w2.x = cvtpk(o20[0], o20[1]); w2.y = cvtpk(o20[2], o20[3]); w2.z = cvtpk(o21[0], o21[1]); w2.w = cvtpk(o21[2], o21[3]);
                    *(u32x4*)(dst + (size_t)r * ld + cb) = w1; *(u32x4*)(dst + (size_t)r * ld + cb + 32) = w2;
                    if (pn == 8) {
                        float* o = nullptr;
                        if (r >= SEQ - 128 && r < SEQ) o = out + O_KP + (size_t)(r - (SEQ - 128)) * 256 + cb;
                        else if (r >= SEQ && r < MR) o = out + O_KS + ((size_t)(r - SEQ) * 128 + 127) * 256 + cb;
                        if (o) { *(f32x4*)o = o10; *(f32x4*)(o + 4) = o11; *(f32x4*)(o + 32) = o20; *(f32x4*)(o + 36) = o21; }
                    }
                }
            }
        } else if (pn == 9) {
#pragma unroll
            for (int ai = 0; ai < 2; ++ai)
#pragma unroll
                for (int m = 0; m < 4; ++m) {
                    const int r = ROW_OF(u, ai, wr, m, fr);
                    float* o = nullptr;
                    if (r >= SEQ - 128 && r < SEQ) o = out + O_VP + (size_t)(r - (SEQ - 128)) * 256;
                    else if (r >= SEQ && r < MR) o = out + O_VS + ((size_t)(r - SEQ) * 128 + 127) * 256;
#pragma unroll
                    for (int bj = 0; bj < 2; ++bj) { const int c = 128 * bj + 32 * wc + 8 * fq; const f32x4 v0 = acc[ai][bj][m][0], v1 = acc[ai][bj][m][1];
                        u32x4 w; w.x = cvtpk(v0[0], v0[1]); w.y = cvtpk(v0[2], v0[3]); w.z = cvtpk(v1[0], v1[1]); w.w = cvtpk(v1[2], v1[3]);
                        *(u32x4*)(Vb + (size_t)r * KVD + c) = w;
                        if (o) { *(f32x4*)(o + c) = v0; *(f32x4*)(o + c + 4) = v1; } }
                }
        } else if (pn < 14) {
#pragma unroll
            for (int ai = 0; ai < 2; ++ai)
#pragma unroll
                for (int m = 0; m < 4; ++m) {
                    const int r = ROW_OF(u, ai, wr, m, fr);
                    float* o = nullptr;
                    if (r >= SEQ - 15 && r < SEQ) o = out + O_PP + (size_t)(r - (SEQ - 15)) * PW;
                    else if (r >= SEQ && r < MR) o = out + O_PS + ((size_t)(r - SEQ) * 15 + 14) * PW;
#pragma unroll
                    for (int bj = 0; bj < 2; ++bj) { const int c = (pn - 10) * 256 + 128 * bj + 32 * wc + 8 * fq; const f32x4 v0 = acc[ai][bj][m][0], v1 = acc[ai][bj][m][1];
                        { u32x4 w; w.x = cvtpk(v0[0], v0[1]); w.y = cvtpk(v0[2], v0[3]); w.z = cvtpk(v1[0], v1[1]); w.w = cvtpk(v1[2], v1[3]); *(u32x4*)((bf16_t*)U + (size_t)r * PW + c) = w; }
                        if (o) { *(f32x4*)(o + c) = v0; *(f32x4*)(o + c + 4) = v1; } }
                }
        } else {
#pragma unroll
            for (int ai = 0; ai < 2; ++ai)
#pragma unroll
                for (int m = 0; m < 4; ++m) {
                    const int r = ROW_OF(u, ai, wr, m, fr);
#pragma unroll
                    for (int bj = 0; bj < 2; ++bj) { const int c = (pn - 14) * 256 + 128 * bj + 32 * wc + 8 * fq; const f32x4 v0 = acc[ai][bj][m][0], v1 = acc[ai][bj][m][1];
                        u32x4 w; w.x = pkh(sigmoidf_(v0[0]), sigmoidf_(v0[1])); w.y = pkh(sigmoidf_(v0[2]), sigmoidf_(v0[3])); w.z = pkh(sigmoidf_(v1[0]), sigmoidf_(v1[1])); w.w = pkh(sigmoidf_(v1[2]), sigmoidf_(v1[3]));
                        *(u32x4*)(SG + (size_t)r * 4096 + c) = w; }
                }
        }
    }
};
struct EpiMix {
    static constexpr bool PERM = true;
    bf16_t* PY; const float* scale;
    __device__ __forceinline__ void operator()(const f32x4 (&acc)[2][2][4][2], const Unit& u, int wr, int wc, int fr, int fq) const {
#pragma unroll
        for (int bj = 0; bj < 2; ++bj) { const int c = u.pn * 256 + 128 * bj + 32 * wc + 8 * fq; const f32x4 s0 = *(const f32x4*)(scale + c), s1 = *(const f32x4*)(scale + c + 4);
#pragma unroll
            for (int ai = 0; ai < 2; ++ai)
#pragma unroll
                for (int m = 0; m < 4; ++m) { const int r = ROW_OF(u, ai, wr, m, fr); const f32x4 v0 = acc[ai][bj][m][0] * s0, v1 = acc[ai][bj][m][1] * s1;
                    u32x4 w; w.x = cvtpk(v0[0], v0[1]); w.y = cvtpk(v0[2], v0[3]); w.z = cvtpk(v1[0], v1[1]); w.w = cvtpk(v1[2], v1[3]);
                    *(u32x4*)(PY + (size_t)r * PW + c) = w; } }
    }
};
struct EpiWeff {
    static constexpr bool PERM = true;
    bf16_t* W;
    __device__ __forceinline__ void operator()(const f32x4 (&acc)[2][2][4][2], const Unit& u, int wr, int wc, int fr, int fq) const {
#pragma unroll
        for (int bj = 0; bj < 2; ++bj) { const int c = u.pn * 256 + 128 * bj + 32 * wc + 8 * fq;
#pragma unroll
            for (int ai = 0; ai < 2; ++ai)
#pragma unroll
                for (int m = 0; m < 4; ++m) { const int r = ROW_OF(u, ai, wr, m, fr); const f32x4 v0 = acc[ai][bj][m][0], v1 = acc[ai][bj][m][1];
                    u32x4 w; w.x = cvtpk(v0[0], v0[1]); w.y = cvtpk(v0[2], v0[3]); w.z = cvtpk(v1[0], v1[1]); w.w = cvtpk(v1[2], v1[3]);
                    *(u32x4*)(W + (size_t)r * DM + c) = w; } }
    }
};
struct EpiBrA {
    static constexpr bool PERM = false;
    float* T1; const unsigned short* SG;
    __device__ __forceinline__ void operator()(const f32x4 (&acc)[2][2][4][2], const Unit& u, int wr, int wc, int fr, int fq) const {
#pragma unroll
        for (int ai = 0; ai < 2; ++ai)
#pragma unroll
            for (int m = 0; m < 4; ++m) { const int r = ROW_OF(u, ai, wr, m, fr); if (r < MR) {
#pragma unroll
                for (int bj = 0; bj < 2; ++bj)
#pragma unroll
                    for (int n = 0; n < 2; ++n) { const int c = u.pn * 256 + 128 * bj + 32 * wc + 16 * n + 4 * fq; const u32x2 gw = *(const u32x2*)(SG + (size_t)r * 4096 + c);
                        const f32x4 gt = {hlo(gw.x), hhi(gw.x), hlo(gw.y), hhi(gw.y)}; *(f32x4*)(T1 + (size_t)r * DM + c) = acc[ai][bj][m][n] * gt; } } }
    }
};
struct EpiBrB {
    static constexpr bool PERM = false;
    const float* T1; const unsigned short* SG; bf16_t* MG;
    __device__ __forceinline__ void operator()(const f32x4 (&acc)[2][2][4][2], const Unit& u, int wr, int wc, int fr, int fq) const {
#pragma unroll
        for (int ai = 0; ai < 2; ++ai)
#pragma unroll
            for (int m = 0; m < 4; ++m) { const int r = ROW_OF(u, ai, wr, m, fr);
#pragma unroll
                for (int bj = 0; bj < 2; ++bj)
#pragma unroll
                    for (int n = 0; n < 2; ++n) { const int c = u.pn * 256 + 128 * bj + 32 * wc + 16 * n + 4 * fq; f32x4 o = {0.f, 0.f, 0.f, 0.f};
                        if (r < MR) { const u32x2 gw = *(const u32x2*)(SG + (size_t)r * 4096 + 2048 + c); const f32x4 gt = {hlo(gw.x), hhi(gw.x), hlo(gw.y), hhi(gw.y)};
                            o = *(const f32x4*)(T1 + (size_t)r * DM + c) + acc[ai][bj][m][n] * gt; }
                        u32x2 w; w.x = cvtpk(o[0], o[1]); w.y = cvtpk(o[2], o[3]); *(u32x2*)(MG + (size_t)r * DM + c) = w; } }
    }
};
struct EpiBr {
    static constexpr bool PERM = false;
    const unsigned short* SG; bf16_t* MG;
    __device__ __forceinline__ void mid(f32x4 (&acc)[2][2][4][2], const Unit& u, int wr, int wc, int fr, int fq) const {
        unsigned o0 = (unsigned)((u.pm * 256 + wr * 64 + fr) * 4096 + u.pn * 256 + 32 * wc + 4 * fq) * 2u; asm volatile("" : "+v"(o0)); const char* sb = (const char*)SG;
#pragma unroll
        for (int ai = 0; ai < 2; ++ai) {
            u32x2 gp[4][2][2], ga[4][2][2];
#pragma unroll
            for (int m = 0; m < 4; ++m)
#pragma unroll
                for (int bj = 0; bj < 2; ++bj)
#pragma unroll
                    for (int n = 0; n < 2; ++n) { const unsigned o = o0 + (unsigned)(((ai * 128 + m * 16) * 4096 + 128 * bj + 16 * n) * 2); gp[m][bj][n] = *(const u32x2*)(sb + o); ga[m][bj][n] = *(const u32x2*)(sb + o + 4096); }
#pragma unroll
            for (int m = 0; m < 4; ++m)
#pragma unroll
                for (int bj = 0; bj < 2; ++bj)
#pragma unroll
                    for (int n = 0; n < 2; ++n) { const u32x2 p_ = gp[m][bj][n], q_ = ga[m][bj][n];
                        f32x4 rt; rt[0] = hlo(p_.x) * __builtin_amdgcn_rcpf(fmaxf(hlo(q_.x), 6.2e-5f)); rt[1] = hhi(p_.x) * __builtin_amdgcn_rcpf(fmaxf(hhi(q_.x), 6.2e-5f));
                        rt[2] = hlo(p_.y) * __builtin_amdgcn_rcpf(fmaxf(hlo(q_.y), 6.2e-5f)); rt[3] = hhi(p_.y) * __builtin_amdgcn_rcpf(fmaxf(hhi(q_.y), 6.2e-5f));
                        acc[ai][bj][m][n] = acc[ai][bj][m][n] * rt; }
            asm volatile("" : "+v"(acc[ai][0][0][0]), "+v"(acc[ai][0][0][1]), "+v"(acc[ai][1][0][0]), "+v"(acc[ai][1][0][1]), "+v"(acc[ai][0][1][0]), "+v"(acc[ai][0][1][1]), "+v"(acc[ai][1][1][0]), "+v"(acc[ai][1][1][1]),
                             "+v"(acc[ai][0][2][0]), "+v"(acc[ai][0][2][1]), "+v"(acc[ai][1][2][0]), "+v"(acc[ai][1][2][1]), "+v"(acc[ai][0][3][0]), "+v"(acc[ai][0][3][1]), "+v"(acc[ai][1][3][0]), "+v"(acc[ai][1][3][1]) :: "memory"); }
    }
    __device__ __forceinline__ void operator()(f32x4 (&acc)[2][2][4][2], const Unit& u, int wr, int wc, int fr, int fq) const {
        unsigned o0 = (unsigned)((u.pm * 256 + wr * 64 + fr) * 4096 + u.pn * 256 + 32 * wc + 4 * fq) * 2u; asm volatile("" : "+v"(o0)); const char* sb = (const char*)SG; char* mb = (char*)MG;
#pragma unroll
        for (int ai = 0; ai < 2; ++ai) {
            u32x2 ga[4][2][2];
#pragma unroll
            for (int m = 0; m < 4; ++m)
#pragma unroll
                for (int bj = 0; bj < 2; ++bj)
#pragma unroll
                    for (int n = 0; n < 2; ++n) { const unsigned o = o0 + (unsigned)(((ai * 128 + m * 16) * 4096 + 128 * bj + 16 * n) * 2); ga[m][bj][n] = *(const u32x2*)(sb + o + 4096); }
#pragma unroll
            for (int m = 0; m < 4; ++m)
#pragma unroll
                for (int bj = 0; bj < 2; ++bj)
#pragma unroll
                    for (int n = 0; n < 2; ++n) { const u32x2 q_ = ga[m][bj][n];
                        const f32x4 q = {fmaxf(hlo(q_.x), 6.2e-5f), fmaxf(hhi(q_.x), 6.2e-5f), fmaxf(hlo(q_.y), 6.2e-5f), fmaxf(hhi(q_.y), 6.2e-5f)};
                        const f32x4 v = acc[ai][bj][m][n] * q; u32x2 w; w.x = cvtpk(v[0], v[1]); w.y = cvtpk(v[2], v[3]);
                        const unsigned row = (unsigned)(u.pm * 256 + wr * 64 + fr + ai * 128 + m * 16), col = (unsigned)(u.pn * 256 + 32 * wc + 4 * fq + 128 * bj + 16 * n);
                        *(u32x2*)(mb + ((size_t)row * DM + col) * 2) = w; }
            asm volatile("" ::: "memory"); }
    }
};
struct EpiOut {
    static constexpr bool PERM = false;
    const float* xp; const float* xs; float* H1;
    __device__ __forceinline__ void operator()(const f32x4 (&acc)[2][2][4][2], const Unit& u, int wr, int wc, int fr, int fq) const {
#pragma unroll
        for (int ai = 0; ai < 2; ++ai)
#pragma unroll
            for (int m = 0; m < 4; ++m) { const int r = ROW_OF(u, ai, wr, m, fr); if (r < MR) { const float* xr = r < SEQ ? xp + (size_t)r * DM : xs + (size_t)(r - SEQ) * DM;
#pragma unroll
                for (int bj = 0; bj < 2; ++bj)
#pragma unroll
                    for (int n = 0; n < 2; ++n) { const int c = u.pn * 256 + 128 * bj + 32 * wc + 16 * n + 4 * fq;
                        *(f32x4*)(H1 + (size_t)r * DM + c) = *(const f32x4*)(xr + c) * ALPHA + acc[ai][bj][m][n]; } } }
    }
};

__device__ __forceinline__ void ln_tile(f32x4 (&v)[2][2][4][2], const Unit& u, int wr, int wc, int fr, int fq, LAS unsigned char* lx, float* rowstat, unsigned* cnt, unsigned want, const float* gam, const float* bet) {
    LAS f32x2* P = (LAS f32x2*)lx; LAS f32x2* S = (LAS f32x2*)(lx + 8192);
    const int tid = (wr * 4 + wc) * 64 + fq * 16 + fr;
#pragma unroll
    for (int ai = 0; ai < 2; ++ai)
#pragma unroll
        for (int m = 0; m < 4; ++m) { float s = 0.f, q = 0.f;
#pragma unroll
            for (int bj = 0; bj < 2; ++bj)
#pragma unroll
                for (int n = 0; n < 2; ++n) { const f32x4 x = v[ai][bj][m][n]; s += (x[0] + x[1]) + (x[2] + x[3]); q += (x[0] * x[0] + x[1] * x[1]) + (x[2] * x[2] + x[3] * x[3]); }
            s += __shfl_xor(s, 16); s += __shfl_xor(s, 32); q += __shfl_xor(q, 16); q += __shfl_xor(q, 32);
            if (fq == 0) P[(ai * 128 + wr * 64 + m * 16 + fr) * 4 + wc] = (f32x2){s, q}; }
    __syncthreads();
    if (tid < 256) { const f32x2 a = P[tid * 4 + 0], b = P[tid * 4 + 1], c = P[tid * 4 + 2], d = P[tid * 4 + 3];
        float* rs = rowstat + (size_t)(u.pm * 256 + tid) * 2;
        (void)__hip_atomic_fetch_add(rs, (a[0] + b[0]) + (c[0] + d[0]), __ATOMIC_RELAXED, __HIP_MEMORY_SCOPE_AGENT);
        (void)__hip_atomic_fetch_add(rs + 1, (a[1] + b[1]) + (c[1] + d[1]), __ATOMIC_RELAXED, __HIP_MEMORY_SCOPE_AGENT); }
    asm volatile("s_waitcnt vmcnt(0)" ::: "memory");
    __syncthreads();
    if (tid == 0) { (void)__hip_atomic_fetch_add(cnt, 1u, __ATOMIC_RELAXED, __HIP_MEMORY_SCOPE_AGENT);
        unsigned sp = 0; while (__hip_atomic_load(cnt, __ATOMIC_RELAXED, __HIP_MEMORY_SCOPE_AGENT) < want) { __builtin_amdgcn_s_sleep(1); if (++sp > (1u << 22)) break; }
        asm volatile("s_waitcnt vmcnt(0)" ::: "memory"); }
    __syncthreads();
    if (tid < 256) { float* rs = rowstat + (size_t)(u.pm * 256 + tid) * 2;
        const float sm = __hip_atomic_load(rs, __ATOMIC_RELAXED, __HIP_MEMORY_SCOPE_AGENT), sq = __hip_atomic_load(rs + 1, __ATOMIC_RELAXED, __HIP_MEMORY_SCOPE_AGENT);
        const float mean = sm * (1.f / DM), var = sq * (1.f / DM) - mean * mean; S[tid] = (f32x2){mean, 1.f / sqrtf(fmaxf(var, 0.f) + LN_EPS)}; }
    __syncthreads();
#pragma unroll
    for (int bj = 0; bj < 2; ++bj)
#pragma unroll
        for (int n = 0; n < 2; ++n) { const int c = u.pn * 256 + 128 * bj + 32 * wc + 16 * n + 4 * fq; const f32x4 g = *(const f32x4*)(gam + c), b = *(const f32x4*)(bet + c);
#pragma unroll
            for (int ai = 0; ai < 2; ++ai)
#pragma unroll
                for (int m = 0; m < 4; ++m) { const f32x2 st = S[ai * 128 + wr * 64 + m * 16 + fr]; v[ai][bj][m][n] = (v[ai][bj][m][n] - st[0]) * st[1] * g + b; } }
}
__device__ __forceinline__ unsigned tile_off0(const Unit& u, int wr, int wc, int fr, int fq) { unsigned o = (unsigned)((u.pm * 256 + wr * 64 + fr) * DM + u.pn * 256 + 32 * wc + 4 * fq) * 4u; asm volatile("" : "+v"(o)); return o; }
#define TILE_OFF(o0, ai, m, bj, n) ((o0) + (unsigned)(((ai) * 128 + (m) * 16) * DM * 4 + (128 * (bj) + 16 * (n)) * 4))
struct EpiOutLN {
    static constexpr bool PERM = false;
    const float* xp; float* Y; bf16_t* XB; LAS unsigned char* lx; float* rowstat; unsigned* cnt; const float* gam; const float* bet;
    __device__ __forceinline__ void operator()(f32x4 (&acc)[2][2][4][2], const Unit& u, int wr, int wc, int fr, int fq) const {
        { const unsigned o0 = tile_off0(u, wr, wc, fr, fq); const char* xb = (const char*)xp;
#pragma unroll
          for (int ai = 0; ai < 2; ++ai)
#pragma unroll
            for (int m = 0; m < 4; ++m) {
#pragma unroll
                for (int bj = 0; bj < 2; ++bj)
#pragma unroll
                    for (int n = 0; n < 2; ++n) acc[ai][bj][m][n] = __builtin_nontemporal_load((const f32x4*)(xb + TILE_OFF(o0, ai, m, bj, n))) * ALPHA + acc[ai][bj][m][n];
                if (m == 3) asm volatile("" : "+v"(acc[ai][0][0][0]), "+v"(acc[ai][0][0][1]), "+v"(acc[ai][1][0][0]), "+v"(acc[ai][1][0][1]), "+v"(acc[ai][0][1][0]), "+v"(acc[ai][0][1][1]), "+v"(acc[ai][1][1][0]), "+v"(acc[ai][1][1][1]),
                                               "+v"(acc[ai][0][2][0]), "+v"(acc[ai][0][2][1]), "+v"(acc[ai][1][2][0]), "+v"(acc[ai][1][2][1]), "+v"(acc[ai][0][3][0]), "+v"(acc[ai][0][3][1]), "+v"(acc[ai][1][3][0]), "+v"(acc[ai][1][3][1]) :: "memory"); } }
        ln_tile(acc, u, wr, wc, fr, fq, lx, rowstat, cnt + 64 * u.pm, 8u, gam, bet);
        { const unsigned o0 = tile_off0(u, wr, wc, fr, fq); char* bb = (char*)XB;
#pragma unroll
          for (int ai = 0; ai < 2; ++ai)
#pragma unroll
            for (int m = 0; m < 4; ++m) {
#pragma unroll
                for (int bj = 0; bj < 2; ++bj)
#pragma unroll
                    for (int n = 0; n < 2; ++n) { const unsigned o = TILE_OFF(o0, ai, m, bj, n); const f32x4 v = acc[ai][bj][m][n];
                        u32x2 w; w.x = cvtpk(v[0], v[1]); w.y = cvtpk(v[2], v[3]); *(u32x2*)(bb + (o >> 1)) = w; }
                asm volatile("" ::: "memory"); } }
    }
};
struct EpiDownLN {
    static constexpr bool PERM = false;
    float* Y; const bf16_t* XB; LAS unsigned char* lx; float* rowstat; unsigned* cnt; const float* gam; const float* bet;
    __device__ __forceinline__ void operator()(f32x4 (&acc)[2][2][4][2], const Unit& u, int wr, int wc, int fr, int fq) const {
        { const unsigned o0 = tile_off0(u, wr, wc, fr, fq); const char* xb = (const char*)XB;
#pragma unroll
          for (int ai = 0; ai < 2; ++ai)
#pragma unroll
            for (int m = 0; m < 4; ++m) {
#pragma unroll
                for (int bj = 0; bj < 2; ++bj)
#pragma unroll
                    for (int n = 0; n < 2; ++n) { const u32x2 xw = __builtin_nontemporal_load((const u32x2*)(xb + (TILE_OFF(o0, ai, m, bj, n) >> 1))); const f32x4 xv = {bflo(xw.x), bfhi(xw.x), bflo(xw.y), bfhi(xw.y)}; acc[ai][bj][m][n] = xv * ALPHA + acc[ai][bj][m][n]; }
                if (m == 3) asm volatile("" : "+v"(acc[ai][0][0][0]), "+v"(acc[ai][0][0][1]), "+v"(acc[ai][1][0][0]), "+v"(acc[ai][1][0][1]), "+v"(acc[ai][0][1][0]), "+v"(acc[ai][0][1][1]), "+v"(acc[ai][1][1][0]), "+v"(acc[ai][1][1][1]),
                                               "+v"(acc[ai][0][2][0]), "+v"(acc[ai][0][2][1]), "+v"(acc[ai][1][2][0]), "+v"(acc[ai][1][2][1]), "+v"(acc[ai][0][3][0]), "+v"(acc[ai][0][3][1]), "+v"(acc[ai][1][3][0]), "+v"(acc[ai][1][3][1]) :: "memory"); } }
        ln_tile(acc, u, wr, wc, fr, fq, lx, rowstat, cnt + 64 * u.pm, 8u, gam, bet);
        { const unsigned o0 = tile_off0(u, wr, wc, fr, fq); char* yb = (char*)Y;
#pragma unroll
          for (int ai = 0; ai < 2; ++ai)
#pragma unroll
            for (int m = 0; m < 4; ++m) {
#pragma unroll
                for (int bj = 0; bj < 2; ++bj)
#pragma unroll
                    for (int n = 0; n < 2; ++n) __builtin_nontemporal_store(acc[ai][bj][m][n], (f32x4*)(yb + TILE_OFF(o0, ai, m, bj, n)));
                asm volatile("" ::: "memory"); } }
    }
};
__device__ __forceinline__ f32x2 ln_thin(f32x2 h, int r, int tid, float* rowstat, unsigned* cnt) {
    float s = h[0] + h[1], q = h[0] * h[0] + h[1] * h[1];
#pragma unroll
    for (int o = 1; o < 16; o <<= 1) { s += __shfl_xor(s, o); q += __shfl_xor(q, o); }
    if ((tid & 15) == 0) { (void)__hip_atomic_fetch_add(rowstat + (size_t)(r - SEQ) * 32, s, __ATOMIC_RELAXED, __HIP_MEMORY_SCOPE_AGENT); (void)__hip_atomic_fetch_add(rowstat + (size_t)(r - SEQ) * 32 + 1, q, __ATOMIC_RELAXED, __HIP_MEMORY_SCOPE_AGENT); }
    asm volatile("s_waitcnt vmcnt(0)" ::: "memory");
    __syncthreads();
    if (tid == 0) { (void)__hip_atomic_fetch_add(cnt, 1u, __ATOMIC_RELAXED, __HIP_MEMORY_SCOPE_AGENT);
        unsigned sp = 0; while (__hip_atomic_load(cnt, __ATOMIC_RELAXED, __HIP_MEMORY_SCOPE_AGENT) < 64u) { __builtin_amdgcn_s_sleep(1); if (++sp > (1u << 22)) break; }
        asm volatile("s_waitcnt vmcnt(0)" ::: "memory"); }
    __syncthreads();
    const float sm = __hip_atomic_load(rowstat + (size_t)(r - SEQ) * 32, __ATOMIC_RELAXED, __HIP_MEMORY_SCOPE_AGENT), sq = __hip_atomic_load(rowstat + (size_t)(r - SEQ) * 32 + 1, __ATOMIC_RELAXED, __HIP_MEMORY_SCOPE_AGENT);
    const float mean = sm * (1.f / DM), var = sq * (1.f / DM) - mean * mean, rstd = 1.f / sqrtf(fmaxf(var, 0.f) + LN_EPS);
    return (h - mean) * rstd;
}
struct EpiGU {
    static constexpr bool PERM = true;
    bf16_t* GU; float* out;
    __device__ __forceinline__ void operator()(const f32x4 (&acc)[2][2][4][2], const Unit& u, int wr, int wc, int fr, int fq) const {
#pragma unroll
        for (int ai = 0; ai < 2; ++ai)
#pragma unroll
            for (int m = 0; m < 4; ++m) { const int r = ROW_OF(u, ai, wr, m, fr);
                float* o = nullptr;
                if (u.pn < 22) { if (r >= SEQ - 2 && r < SEQ) o = out + O_CP + (size_t)(r - (SEQ - 2)) * FF; else if (r >= SEQ && r < MR) o = out + O_CS + ((size_t)(r - SEQ) * 2 + 1) * FF; }
#pragma unroll
                for (int bj = 0; bj < 2; ++bj) { const int c = u.pn * 256 + 128 * bj + 32 * wc + 8 * fq; const f32x4 v0 = acc[ai][bj][m][0], v1 = acc[ai][bj][m][1];
                    u32x4 w; w.x = cvtpk(v0[0], v0[1]); w.y = cvtpk(v0[2], v0[3]); w.z = cvtpk(v1[0], v1[1]); w.w = cvtpk(v1[2], v1[3]);
                    *(u32x4*)((u.pn < 22 ? GU + (size_t)r * FF + c : GU + (size_t)MP * FF + (size_t)r * FF + (c - FF))) = w;
                    if (o) { *(f32x4*)(o + c) = v0; *(f32x4*)(o + c + 4) = v1; } } }
    }
};
struct EpiDown {
    static constexpr bool PERM = false;
    float* Y;
    __device__ __forceinline__ void operator()(const f32x4 (&acc)[2][2][4][2], const Unit& u, int wr, int wc, int fr, int fq) const {
#pragma unroll
        for (int ai = 0; ai < 2; ++ai)
#pragma unroll
            for (int m = 0; m < 4; ++m) { const int r = ROW_OF(u, ai, wr, m, fr); if (r < MR) {
#pragma unroll
                for (int bj = 0; bj < 2; ++bj)
#pragma unroll
                    for (int n = 0; n < 2; ++n) { const int c = u.pn * 256 + 128 * bj + 32 * wc + 16 * n + 4 * fq; float* p = Y + (size_t)r * DM + c;
                        *(f32x4*)p = *(const f32x4*)p * ALPHA + acc[ai][bj][m][n]; } } }
    }
};

__device__ __forceinline__ int map_in_row(int c) {
    if (c >= 2304) return c;
    const int t = c & ~255, l = c & 255; return t + 128 * ((l >> 5) & 1) + 32 * (l >> 6) + (l & 31);
}
template <bool MAPIN>
__device__ __forceinline__ void transpose_item(const float* W, int N, bf16_t* WT, int K, int row_off, int k0, int n0, LAS float* scr, int lane) {
    const int kr = lane >> 4, nc = (lane & 15) * 4;
    f32x4 v[16];
#pragma unroll
    for (int i = 0; i < 16; ++i) v[i] = *(const f32x4*)(W + (size_t)(k0 + 4 * i + kr) * N + n0 + nc);
#pragma unroll
    for (int i = 0; i < 16; ++i) { LAS float* s = scr + (4 * i + kr) * 65 + nc; s[0] = v[i][0]; s[1] = v[i][1]; s[2] = v[i][2]; s[3] = v[i][3]; }
    asm volatile("s_waitcnt lgkmcnt(0)" ::: "memory");
    const int c = lane & 7;
#pragma unroll
    for (int j = 0; j < 8; ++j) { const int n = (lane >> 3) + 8 * j; const LAS float* s = scr + (8 * c) * 65 + n;
        u32x4 o; o.x = cvtpk(s[0], s[65]); o.y = cvtpk(s[2 * 65], s[3 * 65]); o.z = cvtpk(s[4 * 65], s[5 * 65]); o.w = cvtpk(s[6 * 65], s[7 * 65]);
        const int orow = MAPIN ? map_in_row(n0 + n) : (n0 + n);
        *(u32x4*)(WT + (size_t)(row_off + orow) * K + k0 + 8 * c) = o; }
    asm volatile("s_waitcnt lgkmcnt(0)" ::: "memory");
}

struct ConvPtrs { const float *w_in, *w_mix, *w_ab, *w_pb, *w_out, *w_gate, *w_up, *w_down; bf16_t *WinT, *WmixT, *WabT, *WpbT, *WoT, *WguT, *WdT; };
constexpr int CI_IN = 32 * 120, CI_MX = 4 * 16, CI_AB = 32 * 32, CI_PB = 16 * 32, CI_O = 32 * 32, CI_G = 32 * 88, CI_UP = 32 * 88, CI_D = 88 * 32;
constexpr int CI_EARLY = CI_IN + CI_PB, CI_ALL = CI_EARLY + CI_AB + CI_O + CI_G + CI_UP + CI_D;
__device__ __forceinline__ void convert_range(const ConvPtrs& P, int lo, int hi, int gw, int NGW, LAS float* scr, int lane) {
#define T_DECODE(IT, W_, N_, WT_, K_, RO_, K0_, N0_, MI_) do { int r_ = (IT); MI_ = 0; \
        if (r_ < CI_IN) { W_ = P.w_in; N_ = IND; WT_ = P.WinT; K_ = DM; RO_ = 0; K0_ = 64 * (r_ / 120); N0_ = 64 * (r_ % 120); MI_ = 1; break; } r_ -= CI_IN; \
        if (r_ < CI_PB) { W_ = P.w_pb; N_ = DM; WT_ = P.WpbT; K_ = PW; RO_ = 0; K0_ = 64 * (r_ / 32); N0_ = 64 * (r_ % 32); break; } r_ -= CI_PB; \
        if (r_ < CI_AB) { W_ = P.w_ab; N_ = DM; WT_ = P.WabT; K_ = DM; RO_ = 0; K0_ = 64 * (r_ / 32); N0_ = 64 * (r_ % 32); break; } r_ -= CI_AB; \
        if (r_ < CI_O) { W_ = P.w_out; N_ = DM; WT_ = P.WoT; K_ = DM; RO_ = 0; K0_ = 64 * (r_ / 32); N0_ = 64 * (r_ % 32); break; } r_ -= CI_O; \
        if (r_ < CI_G) { W_ = P.w_gate; N_ = FF; WT_ = P.WguT; K_ = DM; RO_ = 0; K0_ = 64 * (r_ / 88); N0_ = 64 * (r_ % 88); break; } r_ -= CI_G; \
        if (r_ < CI_UP) { W_ = P.w_up; N_ = FF; WT_ = P.WguT; K_ = DM; RO_ = FF; K0_ = 64 * (r_ / 88); N0_ = 64 * (r_ % 88); break; } r_ -= CI_UP; \
        { W_ = P.w_down; N_ = DM; WT_ = P.WdT; K_ = FF; RO_ = 0; K0_ = 64 * (r_ / 32); N0_ = 64 * (r_ % 32); } } while (0)
    const int kr = lane >> 4, nc = (lane & 15) * 4, cc = lane & 7;
    f32x4 va[16], vb[16];
    struct Desc { const float* W; bf16_t* WT; int N, K, RO, K0, N0, MI; };
    Desc da = {nullptr, nullptr, 0, 0, 0, 0, 0, 0}, db = da;
    int ita = lo + gw, itb = ita + NGW;
#define T_LOAD(V, D) do { _Pragma("unroll") for (int i = 0; i < 16; ++i) V[i] = __builtin_nontemporal_load((const f32x4*)(D.W + (size_t)(D.K0 + 4 * i + kr) * D.N + D.N0 + nc)); } while (0)
#define T_TOLDS(V) do { _Pragma("unroll") for (int i = 0; i < 16; ++i) { LAS float* sp = scr + (4 * i + kr) * 65 + nc; sp[0] = V[i][0]; sp[1] = V[i][1]; sp[2] = V[i][2]; sp[3] = V[i][3]; } } while (0)
#define T_FINISH(D) do { asm volatile("s_waitcnt lgkmcnt(0)" ::: "memory"); \
        _Pragma("unroll") for (int j = 0; j < 8; ++j) { const int n = (lane >> 3) + 8 * j; const LAS float* sp = scr + (8 * cc) * 65 + n; \
            u32x4 o; o.x = cvtpk(sp[0], sp[65]); o.y = cvtpk(sp[2 * 65], sp[3 * 65]); o.z = cvtpk(sp[4 * 65], sp[5 * 65]); o.w = cvtpk(sp[6 * 65], sp[7 * 65]); \
            const int orow = D.MI ? map_in_row(D.N0 + n) : (D.N0 + n); \
            *(u32x4*)(D.WT + (size_t)(D.RO + orow) * D.K + D.K0 + 8 * cc) = o; } \
        asm volatile("s_waitcnt lgkmcnt(0)" ::: "memory"); } while (0)
    if (ita < hi) { T_DECODE(ita, da.W, da.N, da.WT, da.K, da.RO, da.K0, da.N0, da.MI); T_LOAD(va, da); }
    if (itb < hi) { T_DECODE(itb, db.W, db.N, db.WT, db.K, db.RO, db.K0, db.N0, db.MI); T_LOAD(vb, db); }
    while (ita < hi) {
        { T_TOLDS(va); const Desc cur = da; ita += 2 * NGW;
          if (ita < hi) { T_DECODE(ita, da.W, da.N, da.WT, da.K, da.RO, da.K0, da.N0, da.MI); T_LOAD(va, da); }
          T_FINISH(cur); }
        if (itb < hi) { T_TOLDS(vb); const Desc cur = db; itb += 2 * NGW;
          if (itb < hi) { T_DECODE(itb, db.W, db.N, db.WT, db.K, db.RO, db.K0, db.N0, db.MI); T_LOAD(vb, db); }
          T_FINISH(cur); }
    }
#undef T_LOAD
#undef T_TOLDS
#undef T_FINISH
#undef T_DECODE
}

__device__ __forceinline__ float wave_sum(float v) {
#pragma unroll
    for (int o = 1; o < 64; o <<= 1) v += __shfl_xor(v, o);
    return v;
}
__device__ __forceinline__ float wave_max(float v) {
#pragma unroll
    for (int o = 1; o < 64; o <<= 1) v = fmaxf(v, __shfl_xor(v, o));
    return v;
}
__device__ __forceinline__ void ln_row(const float* src, const float* gam, const float* bet, float* dstF, bf16_t* dstB, int lane) {
    f32x4 v[8]; float s = 0.f;
#pragma unroll
    for (int j = 0; j < 8; ++j) { v[j] = *(const f32x4*)(src + 4 * lane + 256 * j); s += (v[j][0] + v[j][1]) + (v[j][2] + v[j][3]); }
    const float mean = wave_sum(s) * (1.f / DM); float q = 0.f;
#pragma unroll
    for (int j = 0; j < 8; ++j) { v[j] = v[j] - mean; q += (v[j][0] * v[j][0] + v[j][1] * v[j][1]) + (v[j][2] * v[j][2] + v[j][3] * v[j][3]); }
    const float rstd = 1.f / sqrtf(wave_sum(q) * (1.f / DM) + LN_EPS);
#pragma unroll
    for (int j = 0; j < 8; ++j) { const f32x4 g = *(const f32x4*)(gam + 4 * lane + 256 * j), b = *(const f32x4*)(bet + 4 * lane + 256 * j); const f32x4 o = v[j] * rstd * g + b;
        *(f32x4*)(dstF + 4 * lane + 256 * j) = o;
        if (dstB) { u32x2 w; w.x = cvtpk(o[0], o[1]); w.y = cvtpk(o[2], o[3]); *(u32x2*)(dstB + 4 * lane + 256 * j) = w; } }
}

__device__ __forceinline__ int crow(int r, int hi) { return (r & 3) + 8 * (r >> 2) + 4 * hi; }
__device__ __forceinline__ void attn_prompt_unit(LAS unsigned char* lds, int tid, int kvh, int qb, const bf16_t* Q, const bf16_t* Kb, const bf16_t* Vb, bf16_t* AO, const float* sinks) {
    const int lane = tid & 63, w = tid >> 6, q = lane & 31, hi = lane >> 5;
    const int q0 = qb * 32, kb0 = q0 - 128, head = kvh * 8 + w;
    LAS unsigned char* Ks = lds; LAS unsigned char* Vt = lds + 23040;
    bf16x8 qf[4]; const bf16_t* qp = Q + (size_t)(q0 + q) * DM + head * 64 + hi * 8;
#pragma unroll
    for (int dc = 0; dc < 4; ++dc) qf[dc] = *(const bf16x8*)(qp + 16 * dc);
    for (int it = tid; it < 1280; it += 512) {
        const int row = it >> 3, ch = it & 7, kp = kb0 + row;
        u32x4 kv = {0u, 0u, 0u, 0u}, vv = {0u, 0u, 0u, 0u};
        if (kp >= 0) { kv = *(const u32x4*)(Kb + (size_t)kp * KVD + kvh * 64 + ch * 8); vv = *(const u32x4*)(Vb + (size_t)kp * KVD + kvh * 64 + ch * 8); }
        *(LAS u32x4*)(Ks + row * 144 + ch * 16) = kv;
#pragma unroll
        for (int e = 0; e < 8; ++e) { const unsigned wv = vv[e >> 1]; *(LAS unsigned short*)(Vt + (8 * ch + e) * 328 + row * 2) = (unsigned short)((e & 1) ? (wv >> 16) : (wv & 0xffffu)); }
    }
    __syncthreads();
    f32x16 p[5];
#pragma unroll
    for (int j = 0; j < 5; ++j) {
        p[j] = (f32x16){0.f, 0.f, 0.f, 0.f, 0.f, 0.f, 0.f, 0.f, 0.f, 0.f, 0.f, 0.f, 0.f, 0.f, 0.f, 0.f};
#pragma unroll
        for (int dc = 0; dc < 4; ++dc) { const bf16x8 kf = *(const LAS bf16x8*)(Ks + (32 * j + q) * 144 + (16 * dc + 8 * hi) * 2); p[j] = __builtin_amdgcn_mfma_f32_32x32x16_bf16(kf, qf[dc], p[j], 0, 0, 0); }
    }
    const int qpos = q0 + q; float mx = -1e30f;
#pragma unroll
    for (int j = 0; j < 5; ++j)
#pragma unroll
        for (int r = 0; r < 16; ++r) { const int kp = kb0 + 32 * j + crow(r, hi); const bool vis = (kp >= 0) && (kp <= qpos) && (kp > qpos - 128);
            const float s = vis ? p[j][r] : -1e30f; p[j][r] = s; mx = fmaxf(mx, s); }
    mx = fmaxf(mx, __shfl_xor(mx, 32)); const float sk = sinks[head] * LOG2E; mx = fmaxf(mx, sk);
    float l = 0.f;
#pragma unroll
    for (int j = 0; j < 5; ++j)
#pragma unroll
        for (int r = 0; r < 16; ++r) { const float e = __builtin_amdgcn_exp2f(p[j][r] - mx); p[j][r] = e; l += e; }
    l += __shfl_xor(l, 32); const float inv = 1.f / (l + __builtin_amdgcn_exp2f(sk - mx));
    f32x16 o[2];
    o[0] = (f32x16){0.f, 0.f, 0.f, 0.f, 0.f, 0.f, 0.f, 0.f, 0.f, 0.f, 0.f, 0.f, 0.f, 0.f, 0.f, 0.f}; o[1] = o[0];
#pragma unroll
    for (int c = 0; c < 10; ++c) { const int j = c >> 1, h8 = (c & 1) * 8;
        u32x4 pw; pw.x = cvtpk(p[j][h8 + 0], p[j][h8 + 1]); pw.y = cvtpk(p[j][h8 + 2], p[j][h8 + 3]); pw.z = cvtpk(p[j][h8 + 4], p[j][h8 + 5]); pw.w = cvtpk(p[j][h8 + 6], p[j][h8 + 7]);
        const bf16x8 pa = __builtin_bit_cast(bf16x8, pw);
#pragma unroll
        for (int dh = 0; dh < 2; ++dh) { const LAS unsigned char* vp = Vt + (32 * dh + q) * 328 + (16 * c + 4 * hi) * 2;
            const u32x2 lo = *(const LAS u32x2*)vp, hh = *(const LAS u32x2*)(vp + 16); u32x4 vw; vw.x = lo.x; vw.y = lo.y; vw.z = hh.x; vw.w = hh.y;
            o[dh] = __builtin_amdgcn_mfma_f32_32x32x16_bf16(__builtin_bit_cast(bf16x8, vw), pa, o[dh], 0, 0, 0); } }
    bf16_t* op = AO + (size_t)(q0 + q) * DM + head * 64;
#pragma unroll
    for (int dh = 0; dh < 2; ++dh)
#pragma unroll
        for (int g4 = 0; g4 < 4; ++g4) { u32x2 wv; wv.x = cvtpk(o[dh][4 * g4] * inv, o[dh][4 * g4 + 1] * inv); wv.y = cvtpk(o[dh][4 * g4 + 2] * inv, o[dh][4 * g4 + 3] * inv);
            *(u32x2*)(op + 32 * dh + 8 * g4 + 4 * hi) = wv; }
    __syncthreads();
}
__device__ __forceinline__ void attn_sample_unit(LAS unsigned char* lds, int tid, int b, int kvh, const bf16_t* Q, const float* KS, const float* VS, bf16_t* AO, const float* sinks) {
    const int lane = tid & 63, w = tid >> 6;
    LAS float* Ksf = (LAS float*)lds; LAS float* Vsf = (LAS float*)(lds + 33280); LAS float* Qs = (LAS float*)(lds + 66048); LAS float* Ss = (LAS float*)(lds + 68096); LAS float* den = (LAS float*)(lds + 72192);
    for (int it = tid; it < 2048; it += 512) { const int key = it >> 4, ch = it & 15; const size_t off = ((size_t)(b * 128 + key)) * 256 + kvh * 64 + 4 * ch;
        const f32x4 kv = *(const f32x4*)(KS + off), vv = *(const f32x4*)(VS + off);
        LAS float* kd = Ksf + key * 65 + 4 * ch; kd[0] = kv[0]; kd[1] = kv[1]; kd[2] = kv[2]; kd[3] = kv[3];
        *(LAS f32x4*)(Vsf + key * 64 + 4 * ch) = vv; }
    { const int h = tid >> 6, d = tid & 63; Qs[h * 64 + d] = bf2f(Q[(size_t)(SEQ + b) * DM + (kvh * 8 + h) * 64 + d]); }
    __syncthreads();
    { const int key = tid & 127, hg = tid >> 7;
#pragma unroll
      for (int hh = 0; hh < 2; ++hh) { const int h = 2 * hg + hh; float s = 0.f;
#pragma unroll 16
          for (int d = 0; d < 64; ++d) s += Qs[h * 64 + d] * Ksf[key * 65 + d];
          Ss[h * 128 + key] = s; } }
    __syncthreads();
    { const int h = w; const float s0 = Ss[h * 128 + lane], s1 = Ss[h * 128 + 64 + lane]; const float sk = sinks[kvh * 8 + h] * LOG2E;
      const float m = fmaxf(wave_max(fmaxf(s0, s1)), sk); const float e0 = __builtin_amdgcn_exp2f(s0 - m), e1 = __builtin_amdgcn_exp2f(s1 - m);
      const float l = wave_sum(e0 + e1); Ss[h * 128 + lane] = e0; Ss[h * 128 + 64 + lane] = e1; if (lane == 0) den[h] = l + __builtin_amdgcn_exp2f(sk - m); }
    __syncthreads();
    { const int h = tid >> 6, d = tid & 63; float o = 0.f;
#pragma unroll 16
      for (int key = 0; key < 128; ++key) o += Ss[h * 128 + key] * Vsf[key * 64 + d];
      o = o / den[h];
      const unsigned pk = cvtpk(o, 0.f); AO[(size_t)(SEQ + b) * DM + (kvh * 8 + h) * 64 + d] = (bf16_t)(pk & 0xffffu); }
    __syncthreads();
}


__device__ __forceinline__ f32x2 thin_unit(LAS unsigned char* lds, int wave, int lane, const bf16_t* A, int lda, const bf16_t* Bt, int ldb, int K) {
    const int fr = lane & 15, fq = lane >> 4, kw = K >> 3;
    const bf16_t* ap = A + (size_t)fr * lda + wave * kw + 8 * fq;
    const bf16_t* bp = Bt + (size_t)fr * ldb + wave * kw + 8 * fq;
    const size_t a16 = (size_t)16 * lda, b16 = (size_t)16 * ldb;
    f32x4 acc[2][2];
#pragma unroll
    for (int i = 0; i < 2; ++i)
#pragma unroll
        for (int j = 0; j < 2; ++j) acc[i][j] = (f32x4){0.f, 0.f, 0.f, 0.f};
#pragma unroll 4
    for (int k = 0; k < kw; k += 64) {
        bf16x8 af[2][2], bfr[2][2];
#pragma unroll
        for (int i = 0; i < 2; ++i)
#pragma unroll
            for (int st = 0; st < 2; ++st) { af[i][st] = *(const bf16x8*)(ap + i * a16 + k + 32 * st); bfr[i][st] = *(const bf16x8*)(bp + i * b16 + k + 32 * st); }
#pragma unroll
        for (int st = 0; st < 2; ++st)
#pragma unroll
            for (int i = 0; i < 2; ++i)
#pragma unroll
                for (int j = 0; j < 2; ++j) acc[i][j] = __builtin_amdgcn_mfma_f32_16x16x32_bf16(af[i][st], bfr[j][st], acc[i][j], 0, 0, 0);
    }
    LAS float* part = (LAS float*)lds;
#pragma unroll
    for (int i = 0; i < 2; ++i)
#pragma unroll
        for (int j = 0; j < 2; ++j)
#pragma unroll
            for (int q = 0; q < 4; ++q) part[wave * 1024 + (16 * i + 4 * fq + q) * 32 + 16 * j + fr] = acc[i][j][q];
    __syncthreads();
    const int t = wave * 64 + lane; f32x2 o = {0.f, 0.f};
#pragma unroll
    for (int w = 0; w < 8; ++w) { const f32x2 v = *(const LAS f32x2*)(part + w * 1024 + (t >> 4) * 32 + 2 * (t & 15)); o += v; }
    __syncthreads();
    return o;
}

template <int W>
__device__ __forceinline__ void pool_item(const float* U, bf16_t* DP, int r0, int c) {
    f32x4 v[16 + W - 1];
#pragma unroll
    for (int i = 0; i < 16 + W - 1; ++i) { const int r = r0 - (W - 1) + i; u32x2 xw = {0u, 0u}; if (r >= 0) xw = *(const u32x2*)((const bf16_t*)U + (size_t)r * PW + c); v[i] = (f32x4){bflo(xw.x), bfhi(xw.x), bflo(xw.y), bfhi(xw.y)}; }
    f32x4 tot = {0.f, 0.f, 0.f, 0.f};
#pragma unroll
    for (int i = 0; i < W - 1; ++i) tot += v[i];
#pragma unroll
    for (int i = 0; i < 16; ++i) { const int r = r0 + i; tot += v[W - 1 + i]; const float rc = 1.f / (float)(r + 1 < W ? r + 1 : W); const f32x4 d = tot * rc - v[W - 1 + i];
        u32x2 w; w.x = cvtpk(d[0], d[1]); w.y = cvtpk(d[2], d[3]); *(u32x2*)(DP + (size_t)r * DM + c) = w; tot -= v[i]; }
}

__device__ __forceinline__ float gelu_tanh(float x) {
    const float z = 0.7978845608028654f * (x + 0.044715f * x * x * x);
    const float t = __builtin_amdgcn_exp2f(2.885390081777927f * z);
    const float th = 1.f - 2.f * __builtin_amdgcn_rcpf(t + 1.f);
    return 0.5f * x * (1.f + th);
}


#define XB_TMO      128
#define XB_XCNT(j)  (256  + 64 * (j))
#define XB_XSUB(j)  (1280 + 64 * (j))
#define XB_XGEN(j)  (2304 + 64 * (j))
#define XB_TOP      3328
#define XB_TOPGEN   3392
#define XCD_BAR_WORDS 3456
#define XB_SPIN_CAP (1u << 18)
__device__ __forceinline__ unsigned xb_ld(unsigned* p)              { return __hip_atomic_load(p, __ATOMIC_RELAXED, __HIP_MEMORY_SCOPE_AGENT); }
__device__ __forceinline__ unsigned xb_add(unsigned* p, unsigned v) { return __hip_atomic_fetch_add(p, v, __ATOMIC_RELAXED, __HIP_MEMORY_SCOPE_AGENT); }
__device__ __forceinline__ unsigned xb_xcc_id() { return (unsigned)__builtin_amdgcn_s_getreg((3 << 11) | 20) & 0xFu; }
#define XB_SPIN(cond, bar) do { unsigned _sp = 0; while (cond) { __builtin_amdgcn_s_sleep(1); \
    if ((++_sp & 255u) == 0u) { if (xb_ld(&(bar)[XB_TMO])) break; if (_sp > XB_SPIN_CAP) { atomicAdd(&(bar)[XB_TMO], 1u); break; } } } } while (0)
struct XcdBarrier { unsigned* bar; unsigned x; volatile LAS unsigned* st; };
__device__ __forceinline__ void xcd_barrier_complete(unsigned* bar, unsigned x, unsigned& nloc, unsigned& nx) {
    const unsigned G = gridDim.x * gridDim.y * gridDim.z;
    unsigned sum, cnt, mine, sp = 0u;
    for (;;) {
        sum = 0u; cnt = 0u; mine = 0u;
#pragma unroll
        for (unsigned j = 0; j < 16; ++j) { const unsigned c = xb_ld(&bar[XB_XCNT(j)]); sum += c; cnt += (c > 0u) ? 1u : 0u; mine = (j == x) ? c : mine; }
        if (sum == G) break;
        __builtin_amdgcn_s_sleep(1);
        if ((++sp & 255u) == 0u) { if (xb_ld(&bar[XB_TMO])) break; if (sp > XB_SPIN_CAP) { atomicAdd(&bar[XB_TMO], 1u); break; } }
    }
    nloc = mine > 0u ? mine : 1u; nx = cnt > 0u ? cnt : 1u;
}
__device__ __forceinline__ void xcd_barrier(const XcdBarrier& b, bool t0) {
    asm volatile("s_waitcnt vmcnt(0)" ::: "memory");
    __syncthreads();
    if (t0) {
        unsigned* bar = b.bar;
        __builtin_amdgcn_s_waitcnt(0);
        unsigned nloc = b.st[0], nx = b.st[1];
        if (nloc == 0u) { xcd_barrier_complete(bar, b.x, nloc, nx); b.st[0] = nloc; b.st[1] = nx; }
        const unsigned old = xb_add(&bar[XB_XSUB(b.x)], 1u);
        const unsigned gen = old / nloc;
        if (old + 1u == (gen + 1u) * nloc) {
            __builtin_amdgcn_fence(__ATOMIC_RELEASE, "agent");
            asm volatile("s_waitcnt vmcnt(0)" ::: "memory");
            const unsigned og = xb_add(&bar[XB_TOP], 1u);
            const unsigned tg = og / nx;
            if (og + 1u == (tg + 1u) * nx) xb_add(&bar[XB_TOPGEN], 1u);
            else XB_SPIN(xb_ld(&bar[XB_TOPGEN]) == tg, bar);
            __builtin_amdgcn_fence(__ATOMIC_ACQUIRE, "agent");
            xb_add(&bar[XB_XGEN(b.x)], 1u);
            asm volatile("s_waitcnt vmcnt(0)" ::: "memory");
        } else {
            XB_SPIN(xb_ld(&bar[XB_XGEN(b.x)]) == gen, bar);
            __builtin_amdgcn_fence(__ATOMIC_ACQUIRE, "agent");
            asm volatile("s_waitcnt vmcnt(0)" ::: "memory");
        }
    }
    __syncthreads();
}

struct Args { const float* in[22]; float* out; unsigned char* ws; };

__global__ void __launch_bounds__(512, 2) mega_fwd(Args a) {
    extern __shared__ __attribute__((aligned(16))) unsigned char lds_raw[];
    LAS unsigned char* lds = (LAS unsigned char*)lds_raw;
    cg::grid_group grid = cg::this_grid();
    const int wave = __builtin_amdgcn_readfirstlane(threadIdx.x >> 6), G = gridDim.x, bx = blockIdx.x;
    const int gw = bx * 8 + wave, NGW = G * 8;
    const size_t NGT = (size_t)G * 512;
    volatile LAS unsigned* MISC = (volatile LAS unsigned*)(lds + LDS_BYTES - 64);
    if (threadIdx.x < 16) MISC[threadIdx.x] = 0u;
    __syncthreads();
    XcdBarrier xbar; xbar.bar = (unsigned*)(a.ws + WS_CTL); xbar.x = xb_xcc_id(); xbar.st = MISC;
    if (threadIdx.x == 0) (void)xb_add(&xbar.bar[XB_XCNT(xbar.x)], 1u);
    if (G == 0x7fffffff) grid.sync();
#define GRID_SYNC() xcd_barrier(xbar, wave == 0 && lane_fresh() == 0)
#define FRESH_IDS const int lane = lane_fresh(); const int tid = wave * 64 + lane; const size_t gt = (size_t)bx * 512 + tid; (void)gt; (void)tid;
    unsigned char* ws = a.ws; float* out = a.out;
    const float* x_p = a.in[0]; const float* x_s = a.in[1]; const float* cache_k = a.in[2]; const float* cache_v = a.in[3]; const float* st_pool = a.in[4]; const float* st_conv = a.in[5];
    const float* w_in = a.in[6]; const float* sinks = a.in[7]; const float* w_mix = a.in[8]; const float* pool_scale = a.in[9]; const float* w_ab = a.in[10]; const float* w_pb = a.in[11];
    const float* w_out = a.in[12]; const float* ln1g = a.in[13]; const float* ln1b = a.in[14]; const float* w_up = a.in[15]; const float* w_gate = a.in[16]; const float* conv_w = a.in[17];
    const float* conv_b = a.in[18]; const float* w_down = a.in[19]; const float* ln2g = a.in[20]; const float* ln2b = a.in[21];
    bf16_t* WguT = (bf16_t*)(ws + WS_WGU); bf16_t* WdT = (bf16_t*)(ws + WS_WD); bf16_t* R1 = (bf16_t*)(ws + WS_R1);
    bf16_t* WinT = (bf16_t*)(ws + WS_WIN); bf16_t* WabT = (bf16_t*)(ws + WS_WAB); bf16_t* WpbT = (bf16_t*)(ws + WS_WPB); bf16_t* WmixT = (bf16_t*)(ws + WS_WMIX); bf16_t* WoT = (bf16_t*)(ws + WS_WO);
    bf16_t* R2 = (bf16_t*)(ws + WS_R2); float* U = (float*)(ws + WS_U); unsigned short* SG = (unsigned short*)(ws + WS_SG); float* H1 = (float*)(ws + WS_SG);
    bf16_t* Kb = (bf16_t*)(ws + WS_KB); bf16_t* Vb = (bf16_t*)(ws + WS_VB); bf16_t* DP = (bf16_t*)(ws + WS_DP); bf16_t* PY = (bf16_t*)(ws + WS_PY);
    float* COS = (float*)(ws + WS_COS); float* SIN = (float*)(ws + WS_SIN); bf16_t* GU = (bf16_t*)(ws + WS_GU); bf16_t* UB = GU + (size_t)MP * FF;
    const ConvPtrs CP{w_in, w_mix, w_ab, w_pb, w_out, w_gate, w_up, w_down, WinT, WmixT, WabT, WpbT, WoT, WguT, WdT};
    float* Y = out + O_Y;

    {
        FRESH_IDS
        LAS float* scr = (LAS float*)(lds + wave * 16640);
        convert_range(CP, 0, CI_EARLY, gw, NGW, scr, lane);
        for (size_t i0 = gt; i0 < (size_t)MP * DM / 8; i0 += 4 * NGT) {
            f32x4 a0[4], a1[4];
#pragma unroll
            for (int u = 0; u < 4; ++u) { const size_t e = (i0 + u * NGT) * 8; const int r = (int)(e / DM), c = (int)(e % DM); a0[u] = (f32x4){0.f, 0.f, 0.f, 0.f}; a1[u] = a0[u];
                if (r < MR) { const float* src = r < SEQ ? x_p + (size_t)r * DM + c : x_s + (size_t)(r - SEQ) * DM + c; a0[u] = __builtin_nontemporal_load((const f32x4*)src); a1[u] = __builtin_nontemporal_load((const f32x4*)(src + 4)); } }
#pragma unroll
            for (int u = 0; u < 4; ++u) { const size_t e = (i0 + u * NGT) * 8; if (e < (size_t)MP * DM) { u32x4 w; w.x = cvtpk(a0[u][0], a0[u][1]); w.y = cvtpk(a0[u][2], a0[u][3]); w.z = cvtpk(a1[u][0], a1[u][1]); w.w = cvtpk(a1[u][2], a1[u][3]);
                *(u32x4*)(R1 + e) = w; } }
        }
        for (size_t i = gt; i < (size_t)4 * 256 * 256 / 8; i += NGT) { const size_t e = i * 8; const int g = (int)(e >> 16), d = (int)(e & 255);
            const f32x4 a0 = *(const f32x4*)(w_mix + e), a1 = *(const f32x4*)(w_mix + e + 4), s0 = *(const f32x4*)(pool_scale + 256 * g + d), s1 = *(const f32x4*)(pool_scale + 256 * g + d + 4);
            const f32x4 p0 = a0 * s0, p1 = a1 * s1; u32x4 w; w.x = cvtpk(p0[0], p0[1]); w.y = cvtpk(p0[2], p0[3]); w.z = cvtpk(p1[0], p1[1]); w.w = cvtpk(p1[2], p1[3]); *(u32x4*)(WmixT + e) = w; }
        for (size_t i = gt; i < (size_t)(SEQ + 1) * 32; i += NGT) { const int pos = (int)(i >> 5), j = (int)(i & 31);
            const double inv = exp2(-(double)j * (13.287712379549449 / 32.0)); const double ang = (double)pos * inv; COS[i] = (float)cos(ang); SIN[i] = (float)sin(ang); }
    }
    GRID_SYNC();

    {
        if ((bx & 1) == 0) { FRESH_IDS convert_range(CP, CI_EARLY, G == 256 ? CI_ALL - CI_D : CI_ALL, gw, NGW, (LAS float*)(lds + wave * 16640), lane);
        const size_t gt2 = (size_t)(bx >> 1) * 512 + tid, NGT2 = (size_t)((G + 1) >> 1) * 512; (void)gt2;
        for (size_t i0 = gt2; i0 < (size_t)NSMP * 127 * 64; i0 += 4 * NGT2) {
            f32x4 kk[4], vv[4];
#pragma unroll
            for (int u = 0; u < 4; ++u) { const size_t i = i0 + u * NGT2; if (i < (size_t)NSMP * 127 * 64) { const size_t b = i / (127 * 64), rem = i % (127 * 64); const size_t so = (b * 128 + 1) * 256 + rem * 4;
                kk[u] = __builtin_nontemporal_load((const f32x4*)(cache_k + so)); } }
#pragma unroll
            for (int u = 0; u < 4; ++u) { const size_t i = i0 + u * NGT2; if (i < (size_t)NSMP * 127 * 64) { const size_t b = i / (127 * 64), rem = i % (127 * 64); const size_t dof = b * 128 * 256 + rem * 4;
                *(f32x4*)(out + O_KS + dof) = kk[u]; } }
        }
        for (size_t i = gt2; i < (size_t)NSMP * 14 * 256; i += NGT2) { const size_t b = i / (14 * 256), rem = i % (14 * 256);
            *(f32x4*)(out + O_PS + b * 15 * PW + rem * 4) = *(const f32x4*)(st_pool + (b * 15 + 1) * PW + rem * 4); }
            __syncthreads(); }
        { pg8::Gemm g{R1, WinT, DM, DM, DM, 0}; pg8::StaticOrder S; S.init(MP, IND, G, bx);
          EpiIn E{R2, Kb, Vb, U, SG, COS, SIN, out};
          pg8::gemm_phase<EpiIn>(lds, g, S, E, wave); }
        { const int first = (G == 256) ? 222 : 0;
          if (bx >= first && bx < first + 32) { pg8::Gemm g{WpbT, WmixT, 256, PW, 256, 256}; pg8::StaticOrder S; S.init(DM, PW, 32, bx - first); EpiWeff E{PY}; pg8::gemm_phase<EpiWeff>(lds, g, S, E, wave); } }
        if ((bx & 1) != 0) { FRESH_IDS convert_range(CP, CI_EARLY, G == 256 ? CI_ALL - CI_D : CI_ALL, gw, NGW, (LAS float*)(lds + wave * 16640), lane);
        const size_t gt2 = (size_t)(bx >> 1) * 512 + tid, NGT2 = (size_t)((G + 1) >> 1) * 512; (void)gt2;
        for (size_t i0 = gt2; i0 < (size_t)NSMP * 127 * 64; i0 += 4 * NGT2) {
            f32x4 kk[4], vv[4];
#pragma unroll
            for (int u = 0; u < 4; ++u) { const size_t i = i0 + u * NGT2; if (i < (size_t)NSMP * 127 * 64) { const size_t b = i / (127 * 64), rem = i % (127 * 64); const size_t so = (b * 128 + 1) * 256 + rem * 4;
                 vv[u] = __builtin_nontemporal_load((const f32x4*)(cache_v + so)); } }
#pragma unroll
            for (int u = 0; u < 4; ++u) { const size_t i = i0 + u * NGT2; if (i < (size_t)NSMP * 127 * 64) { const size_t b = i / (127 * 64), rem = i % (127 * 64); const size_t dof = b * 128 * 256 + rem * 4;
                 *(f32x4*)(out + O_VS + dof) = vv[u]; } }
        }
        for (size_t i = gt2; i < (size_t)NSMP * (FF / 4); i += NGT2) { const size_t b = i / (FF / 4), rem = i % (FF / 4);
            *(f32x4*)(out + O_CS + b * 2 * FF + rem * 4) = *(const f32x4*)(st_conv + (b * 2 + 1) * FF + rem * 4); }
        }
    }
    GRID_SYNC();

    {
        FRESH_IDS
        bf16_t* AO = R1;
        for (int id = bx; id < 1024; id += G) attn_prompt_unit(lds, tid, id & 3, id >> 2, R2, Kb, Vb, AO, sinks);
        for (int id = bx; id < 512; id += G) attn_sample_unit(lds, tid, id >> 2, id & 3, R2, out + O_KS, out + O_VS, AO, sinks);
        const size_t NPI = (size_t)(SEQ / 16) * 256, NSI = (size_t)NSMP * 256;
        for (size_t it = gt; it < NPI + NSI; it += NGT) {
            if (it < NPI) {
                const int rb = (int)(it >> 8), c = (int)(it & 255) * 4, g = c >> 8, r0 = rb * 16;
                if (g == 0) pool_item<2>(U, DP, r0, c); else if (g == 1) pool_item<4>(U, DP, r0, c); else if (g == 2) pool_item<8>(U, DP, r0, c); else pool_item<16>(U, DP, r0, c);
            } else {
                const size_t k = it - NPI; const int b = (int)(k >> 8), c = (int)(k & 255) * 4, wdw = 2 << (c >> 8), r = SEQ + b;
                const u32x2 xw = *(const u32x2*)((const bf16_t*)U + (size_t)r * PW + c); const f32x4 cur = {bflo(xw.x), bfhi(xw.x), bflo(xw.y), bfhi(xw.y)}; f32x4 tot = cur;
                for (int j = 1; j < wdw; ++j) tot += *(const f32x4*)(st_pool + ((size_t)b * 15 + (15 - j)) * PW + c);
                const f32x4 d = tot * (1.f / (float)wdw) - cur;
                u32x2 w; w.x = cvtpk(d[0], d[1]); w.y = cvtpk(d[2], d[3]); *(u32x2*)(DP + (size_t)r * DM + c) = w;
            }
        }
    }
    GRID_SYNC();

    {
        { pg8::Gemm g0{DP, PY  , PW, DM, DM, 0}; pg8::Gemm g1{R1  , WabT, DM, DM, DM, 0}; pg8::StaticOrder S; S.init(SEQ, DM, G, bx); EpiBr E{SG, R2}; pg8::gemm_phase2<EpiBr>(lds, g0, g1, S, E, wave); }
        { FRESH_IDS
          for (int id = bx; id < 256; id += G) { const int r0 = SEQ + 32 * (id & 3), c0 = 32 * (id >> 2);
              const f32x2 va = thin_unit(lds, wave, lane, DP + (size_t)r0 * DM, DM, PY + (size_t)c0 * DM, DM, PW);
              const f32x2 vb = thin_unit(lds, wave, lane, R1 + (size_t)r0 * DM, DM, WabT + (size_t)c0 * DM, DM, DM);
              const int r = r0 + (tid >> 4), c = c0 + 2 * (tid & 15);
              const unsigned gp = *(const unsigned*)(SG + (size_t)r * 4096 + c), ga = *(const unsigned*)(SG + (size_t)r * 4096 + 2048 + c);
              *(unsigned*)(R2 + (size_t)r * DM + c) = cvtpk(hlo(gp) * va[0] + hlo(ga) * vb[0], hhi(gp) * va[1] + hhi(ga) * vb[1]); } }
    }
    GRID_SYNC();

    {
        unsigned* ctl = (unsigned*)(ws + WS_CTL); float* rs1 = (float*)(ctl + CW_RS1);
        if (G == 256) { pg8::Gemm g{R2, WoT, DM, DM, DM, 0}; pg8::StaticOrder S; S.init(SEQ, DM, G, bx); EpiOutLN E{x_p, Y, R1, lds + 131072, rs1, ctl + CW_CNT, ln1g, ln1b}; pg8::gemm_phase<EpiOutLN>(lds, g, S, E, wave); }
        { FRESH_IDS
          if (G == 256) { const int id = bx; const int r0 = SEQ + 32 * (id & 3), c0 = 32 * (id >> 2);
              const f32x2 v = thin_unit(lds, wave, lane, R2 + (size_t)r0 * DM, DM, WoT + (size_t)c0 * DM, DM, DM);
              const int r = r0 + (tid >> 4), c = c0 + 2 * (tid & 15);
              const f32x2 xv = *(const f32x2*)(x_s + (size_t)(r - SEQ) * DM + c);
              const f32x2 z = ln_thin(xv * ALPHA + v, r, tid, (float*)(ctl + CW_TS1), ctl + CW_CNT + 2048 + 64 * (id & 3));
              const f32x2 o = z * *(const f32x2*)(ln1g + c) + *(const f32x2*)(ln1b + c);
              *(f32x2*)(Y + (size_t)r * DM + c) = o; *(unsigned*)(R1 + (size_t)r * DM + c) = cvtpk(o[0], o[1]); } }
    }
    GRID_SYNC();

    {
        pg8::Gemm g{R1, WguT, DM, DM, DM, 0}; pg8::StaticOrder S; S.init(MP, 2 * FF, G, bx, 3); EpiGU E{GU, out}; pg8::gemm_phase<EpiGU>(lds, g, S, E, wave);
        if (G == 256 && bx >= 172) { FRESH_IDS convert_range(CP, CI_ALL - CI_D, CI_ALL, gw - 172 * 8, 84 * 8, (LAS float*)(lds + wave * 16640), lane); }
    }
    GRID_SYNC();

    { FRESH_IDS
      const size_t NPI = (size_t)(SEQ / 8) * (FF / 8), NSI = (size_t)NSMP * (FF / 8);
      for (size_t it = gt; it < NPI + NSI; it += NGT) {
          const bool smp = it >= NPI; const size_t k = smp ? it - NPI : it;
          const int rb = (int)(k / (FF / 8)), c = (int)(k % (FF / 8)) * 8;
          f32x4 cw[3][2], cb[2];
#pragma unroll
          for (int h = 0; h < 2; ++h) { cb[h] = *(const f32x4*)(conv_b + c + 4 * h);
#pragma unroll
              for (int j = 0; j < 3; ++j) cw[j][h] = *(const f32x4*)(conv_w + (size_t)j * FF + c + 4 * h); }
          if (!smp) {
              const int r0 = rb * 8; u32x4 gw_[10], uw[8];
#pragma unroll
              for (int i = 0; i < 10; ++i) { const int r = r0 - 2 + i; gw_[i] = r >= 0 ? *(const u32x4*)(GU + (size_t)r * FF + c) : (u32x4){0u, 0u, 0u, 0u}; }
#pragma unroll
              for (int i = 0; i < 8; ++i) uw[i] = *(const u32x4*)(UB + (size_t)(r0 + i) * FF + c);
#pragma unroll
              for (int i = 0; i < 8; ++i) { u32x4 wo;
#pragma unroll
                  for (int h = 0; h < 2; ++h) {
                      const f32x4 g0 = {bflo(gw_[i][2 * h]), bfhi(gw_[i][2 * h]), bflo(gw_[i][2 * h + 1]), bfhi(gw_[i][2 * h + 1])};
                      const f32x4 g1 = {bflo(gw_[i + 1][2 * h]), bfhi(gw_[i + 1][2 * h]), bflo(gw_[i + 1][2 * h + 1]), bfhi(gw_[i + 1][2 * h + 1])};
                      const f32x4 g2 = {bflo(gw_[i + 2][2 * h]), bfhi(gw_[i + 2][2 * h]), bflo(gw_[i + 2][2 * h + 1]), bfhi(gw_[i + 2][2 * h + 1])};
                      const f32x4 up = {bflo(uw[i][2 * h]), bfhi(uw[i][2 * h]), bflo(uw[i][2 * h + 1]), bfhi(uw[i][2 * h + 1])};
                      const f32x4 y = cb[h] + cw[0][h] * g0 + cw[1][h] * g1 + cw[2][h] * g2;
                      const f32x4 hv = {gelu_tanh(y[0]) * up[0], gelu_tanh(y[1]) * up[1], gelu_tanh(y[2]) * up[2], gelu_tanh(y[3]) * up[3]};
                      wo[2 * h] = cvtpk(hv[0], hv[1]); wo[2 * h + 1] = cvtpk(hv[2], hv[3]); }
                  *(u32x4*)(UB + (size_t)(r0 + i) * FF + c) = wo; }
          } else {
              const int r = SEQ + rb; const float* h0 = st_conv + (size_t)rb * 2 * FF + c;
              const u32x4 gwv = *(const u32x4*)(GU + (size_t)r * FF + c), uwv = *(const u32x4*)(UB + (size_t)r * FF + c); u32x4 wo;
#pragma unroll
              for (int h = 0; h < 2; ++h) {
                  const f32x4 g0 = *(const f32x4*)(h0 + 4 * h), g1 = *(const f32x4*)(h0 + FF + 4 * h);
                  const f32x4 g2 = {bflo(gwv[2 * h]), bfhi(gwv[2 * h]), bflo(gwv[2 * h + 1]), bfhi(gwv[2 * h + 1])};
                  const f32x4 up = {bflo(uwv[2 * h]), bfhi(uwv[2 * h]), bflo(uwv[2 * h + 1]), bfhi(uwv[2 * h + 1])};
                  const f32x4 y = cb[h] + cw[0][h] * g0 + cw[1][h] * g1 + cw[2][h] * g2;
                  const f32x4 hv = {gelu_tanh(y[0]) * up[0], gelu_tanh(y[1]) * up[1], gelu_tanh(y[2]) * up[2], gelu_tanh(y[3]) * up[3]};
                  wo[2 * h] = cvtpk(hv[0], hv[1]); wo[2 * h + 1] = cvtpk(hv[2], hv[3]); }
              *(u32x4*)(UB + (size_t)r * FF + c) = wo;
          }
      } }
    GRID_SYNC();

    {
        unsigned* ctl = (unsigned*)(ws + WS_CTL); float* rs2 = (float*)(ctl + CW_RS2);
        if (G == 256) { pg8::Gemm g{UB, WdT, FF, FF, FF, 0}; pg8::StaticOrder S; S.init(SEQ, DM, G, bx); EpiDownLN E{Y, R1, lds + 131072, rs2, ctl + CW_CNT + 4096, ln2g, ln2b}; pg8::gemm_phase<EpiDownLN>(lds, g, S, E, wave); }
        { FRESH_IDS
          if (G == 256) { const int id = bx; const int r0 = SEQ + 32 * (id & 3), c0 = 32 * (id >> 2);
              const f32x2 v = thin_unit(lds, wave, lane, UB + (size_t)r0 * FF, FF, WdT + (size_t)c0 * FF, FF, FF);
              const int r = r0 + (tid >> 4), c = c0 + 2 * (tid & 15);
              float* yp = Y + (size_t)r * DM + c;
              const f32x2 z = ln_thin(*(const f32x2*)yp * ALPHA + v, r, tid, (float*)(ctl + CW_TS2), ctl + CW_CNT + 6144 + 64 * (id & 3));
              *(f32x2*)yp = z * *(const f32x2*)(ln2g + c) + *(const f32x2*)(ln2b + c); } }
    }
}

extern "C" void kernel_launch(void* const* d_in, const int* in_sizes, int n_in, void* d_out, int out_size, void* d_ws, size_t ws_size, hipStream_t stream) {
    static int grid = 0;
    if (grid == 0) {
        if (n_in != 22 || ws_size < WS_TOTAL) { fprintf(stderr, "kernel_launch: need 22 inputs and >= %zu bytes of workspace (got %d, %zu)\n", (size_t)WS_TOTAL, n_in, ws_size); grid = -1; return; }
        int dev = 0, cus = 0, per_cu = 0;
        (void)hipGetDevice(&dev); (void)hipDeviceGetAttribute(&cus, hipDeviceAttributeMultiprocessorCount, dev);
        (void)hipFuncSetAttribute((const void*)mega_fwd, hipFuncAttributeMaxDynamicSharedMemorySize, LDS_BYTES);
        if (hipOccupancyMaxActiveBlocksPerMultiprocessor(&per_cu, (const void*)mega_fwd, 512, LDS_BYTES) != hipSuccess || per_cu < 1) { fprintf(stderr, "kernel_launch: occupancy query says %d blocks per CU\n", per_cu); per_cu = 1; }
        (void)hipGetLastError();
        grid = cus;
    }
    if (grid < 0) return;
    (void)hipMemsetAsync((char*)d_ws + WS_CTL, 0, CTL_BYTES, stream);
    Args a{};
    for (int i = 0; i < 22; ++i) a.in[i] = (const float*)d_in[i];
    a.out = (float*)d_out; a.ws = (unsigned char*)d_ws;
    void* args[] = {&a};
    hipError_t e = hipLaunchCooperativeKernel((const void*)mega_fwd, dim3(grid), dim3(512), args, LDS_BYTES, stream);
    if (e != hipSuccess) fprintf(stderr, "cooperative launch failed: %s (grid %d)\n", hipGetErrorString(e), grid);
}
```

```cpp
#include <hip/hip_runtime.h>
#include <hip/hip_cooperative_groups.h>
#include <cstdio>
#include <cstdint>
namespace cg = cooperative_groups;

#define LAS __attribute__((address_space(3)))
typedef unsigned short bf16_t;
typedef short bf16x8 __attribute__((ext_vector_type(8)));
typedef float f32x4 __attribute__((ext_vector_type(4)));
typedef float f32x2 __attribute__((ext_vector_type(2)));
typedef float f32x16 __attribute__((ext_vector_type(16)));
typedef unsigned u32x4 __attribute__((ext_vector_type(4)));
typedef unsigned u32x2 __attribute__((ext_vector_type(2)));
typedef __bf16 bf16x2_t __attribute__((ext_vector_type(2)));
typedef _Float16 h2_t __attribute__((ext_vector_type(2)));

constexpr int DM = 2048, SEQ = 8192, NSMP = 128, MR = SEQ + NSMP  , MP = 8448  ;
constexpr int KVD = 256, PW = 1024, FF = 5632, IND = 7680, NH = 32, HD = 64;
constexpr float LN_EPS = 1e-5f;
constexpr float LOG2E = 1.4426950408889634f;
constexpr float QSCALE = 0.125f * LOG2E;
constexpr float ALPHA = 1.189207115002721f;

constexpr size_t O_Y = 0, O_KP = 17039360, O_VP = 17072128, O_PP = 17104896, O_CP = 17120256, O_KS = 17131520, O_VS = 21325824, O_PS = 25520128, O_CS = 27486208;

constexpr size_t MiB = 1u << 20;
constexpr size_t WS_WGU = 0, WS_WD = 44 * MiB, WS_R1 = 66 * MiB  , WS_EARLY = 99 * MiB;
constexpr size_t WS_WIN = WS_EARLY, WS_WAB = WS_WIN + 30 * MiB, WS_WPB = WS_WAB + 8 * MiB, WS_WMIX = WS_WPB + 4 * MiB, WS_WO = WS_WMIX + 1 * MiB;
constexpr size_t WS_R2 = WS_WO + 8 * MiB  , WS_U = WS_R2 + 33 * MiB, WS_SG = WS_U + 33 * MiB  , WS_KB = WS_SG + 66 * MiB, WS_VB = WS_KB + 5 * MiB;
constexpr size_t WS_DP = WS_VB + 5 * MiB  , WS_PY = WS_DP + 33 * MiB  , WS_COS = WS_PY + 8 * MiB, WS_SIN = WS_COS + 2 * MiB, WS_END = WS_SIN + 2 * MiB;
constexpr size_t WS_GU = WS_EARLY;
static_assert(WS_END == 337 * MiB, "ws map");
constexpr size_t WS_CTL = WS_END, CTL_BYTES = 262144, WS_TOTAL = WS_CTL + CTL_BYTES;
constexpr int CW_RS1 = 4096, CW_RS2 = 21504, CW_CNT = 38912, CW_TS1 = 49152, CW_TS2 = 53248;
static_assert((CW_TS2 + 4096) * 4 <= (int)CTL_BYTES, "ctl map 2");
constexpr int CW_UNUSED_ = 0;
static_assert((CW_CNT + 6400) * 4 <= (int)CTL_BYTES && CW_RS1 + 2 * 8320 <= CW_RS2 && CW_RS2 + 2 * 8320 <= CW_CNT, "ctl map");
static_assert(WS_GU + (size_t)MP * 2 * FF * 2 <= WS_END, "GU overlay");

constexpr int LDS_BYTES = 147456;

__device__ __forceinline__ int lane_fresh() { int l; asm volatile("v_mbcnt_lo_u32_b32 %0, -1, 0\n\tv_mbcnt_hi_u32_b32 %0, -1, %0" : "=v"(l)); return l; }
__device__ __forceinline__ unsigned cvtpk(float lo, float hi) { f32x2 v = {lo, hi}; bf16x2_t b = __builtin_convertvector(v, bf16x2_t); return __builtin_bit_cast(unsigned, b); }
__device__ __forceinline__ float bf2f(unsigned short h) { return __builtin_bit_cast(float, (unsigned)h << 16); }
__device__ __forceinline__ float bflo(unsigned w) { return __builtin_bit_cast(float, w << 16); }
__device__ __forceinline__ float bfhi(unsigned w) { return __builtin_bit_cast(float, w & 0xffff0000u); }
__device__ __forceinline__ unsigned pkh(float a, float b) { h2_t v = {(_Float16)a, (_Float16)b}; return __builtin_bit_cast(unsigned, v); }
__device__ __forceinline__ float hlo(unsigned w) { h2_t v = __builtin_bit_cast(h2_t, w); return (float)v.x; }
__device__ __forceinline__ float hhi(unsigned w) { h2_t v = __builtin_bit_cast(h2_t, w); return (float)v.y; }
__device__ __forceinline__ float sigmoidf_(float v) { return __builtin_amdgcn_rcpf(1.f + __builtin_amdgcn_exp2f(-1.4426950408889634f * v)); }

namespace pg8 {
constexpr int BM = 256, BK = 64, HALF = 128, HTB = HALF * BK * 2, STAGE_BYTES = 8 * HTB, NXCD = 8, WGM = 8;
__host__ __device__ __forceinline__ int lds_byte(int r, int c) { const int st = (r >> 4) * 2 + (c >> 5), rr = r & 15, cc = c & 31, ob = rr * 64 + cc * 2; return st * 1024 + (ob ^ (((ob >> 9) & 1) << 5)); }
__host__ __device__ __forceinline__ void stage_rc(int b, int& R, int& C) { const int st = b / 1024, sb = b % 1024, swz = sb ^ (((sb >> 9) & 1) << 5); R = (st >> 1) * 16 + swz / 64; C = (st & 1) * 32 + (swz % 64) / 2; }
__host__ __device__ __forceinline__ int perm32(int rho) { const int n = rho >> 4, i = rho & 15; return 8 * (i >> 2) + 4 * n + (i & 3); }
struct Unit { int pm, pn; };
struct Gemm { const bf16_t* A; const bf16_t* Bt; int K, lda, ldb, acol; };
struct StaticOrder {
    int nM, nN, nwg, G, c, wgm;
    __device__ void init(int M, int N, int G_, int c_, int wgm_ = WGM) { nM = M / BM; nN = N / BM; nwg = nM * nN; G = G_; c = c_; wgm = wgm_; }
    __device__ bool next(int i, Unit& u) const {
        const long L = (long)i * G + c; if (L >= nwg) return false;
        int wgid = (int)L; { const int q = nwg / NXCD, r = nwg % NXCD, xcd = wgid % NXCD, off = wgid / NXCD; wgid = (xcd < r ? xcd * (q + 1) : r * (q + 1) + (xcd - r) * q) + off; }
        const int nig = wgm * nN, gid = wgid / nig, fm = gid * wgm, gsz = (nM - fm) < wgm ? (nM - fm) : wgm;
        u.pm = fm + ((wgid % nig) % gsz); u.pn = (wgid % nig) / gsz; return true;
    }
};
template <class Epi>
__device__ __forceinline__ void gemm_phase(LAS unsigned char* lds, const Gemm g, const StaticOrder& S, const Epi& E, int wid) {
    const int lane = lane_fresh(), tid = wid * 64 + lane, wr = wid >> 2, wc = wid & 3, fr = lane & 15, fq = lane >> 4;
    int K = g.K; asm volatile("" : "+s"(K));
    const int nt = K / BK;
    unsigned voffA[2], voffB[2];
#pragma unroll
    for (int i = 0; i < 2; ++i) { int R, C; stage_rc(tid * 16 + i * 8192, R, C); const int Rb = Epi::PERM ? ((R & ~31) + perm32(R & 31)) : R;
        voffA[i] = (unsigned)(R * g.lda + C) * 2u; voffB[i] = (unsigned)(Rb * g.ldb + C) * 2u; }
    const size_t kstep = (size_t)(BK * 2);
    const size_t hsA = (size_t)HALF * g.lda * 2, hsB = (size_t)HALF * g.ldb * 2;
    const unsigned ldsw = (unsigned)wid * 1024u;
    const int aoff = lds_byte(wr * 64 + fr, fq * 8), boff = lds_byte(wc * 32 + fr, fq * 8);
#define PG8_SA(b, h) (((b) * 2 + (h)) * HTB)
#define PG8_SB(b, h) ((4 + (b) * 2 + (h)) * HTB)
#define PG8_STAGE(bufoff, gbase, voff) do { _Pragma("unroll") for (int _i = 0; _i < 2; ++_i) \
        __builtin_amdgcn_global_load_lds((const unsigned*)((const char*)(gbase) + (voff)[_i]), (LAS unsigned*)(lds + (bufoff) + ldsw + _i * 8192), 16, 0, 0); } while (0)
#define PG8_LDA(dst, b, h) do { _Pragma("unroll") for (int m = 0; m < 4; ++m) _Pragma("unroll") for (int k = 0; k < 2; ++k) dst[m][k] = *(const LAS bf16x8*)(lds + PG8_SA(b, h) + aoff + m * 2048 + k * 1024); } while (0)
#define PG8_LDB(dst, b, h) do { _Pragma("unroll") for (int n = 0; n < 2; ++n) _Pragma("unroll") for (int k = 0; k < 2; ++k) dst[n][k] = *(const LAS bf16x8*)(lds + PG8_SB(b, h) + boff + n * 2048 + k * 1024); } while (0)
#define PG8_MMA(ai, bj, At, Bt) do { __builtin_amdgcn_s_setprio(1); _Pragma("unroll") for (int m = 0; m < 4; ++m) _Pragma("unroll") for (int n = 0; n < 2; ++n) _Pragma("unroll") for (int k = 0; k < 2; ++k) \
        acc[ai][bj][m][n] = __builtin_amdgcn_mfma_f32_16x16x32_bf16(Bt[n][k], At[m][k], acc[ai][bj][m][n], 0, 0, 0); __builtin_amdgcn_s_setprio(0); } while (0)
#define PG8_WAIT_V(n) asm volatile("s_waitcnt vmcnt(" #n ")" ::: "memory")
#define PG8_WAIT_L(n) asm volatile("s_waitcnt lgkmcnt(" #n ")" ::: "memory")
#define PG8_BAR __builtin_amdgcn_s_barrier()
#define PG8_SCHED __builtin_amdgcn_sched_barrier(0)
    Unit cur, nxt; int ui = 0;
    if (!S.next(0, cur)) return;
    f32x4 acc[2][2][4][2];
#pragma unroll
    for (int a = 0; a < 2; ++a)
#pragma unroll
        for (int b = 0; b < 2; ++b)
#pragma unroll
            for (int m = 0; m < 4; ++m)
#pragma unroll
                for (int n = 0; n < 2; ++n) acc[a][b][m][n] = (f32x4){0.f, 0.f, 0.f, 0.f};
    bf16x8 At[4][2], B0[2][2], B1[2][2];
    const char* cA = (const char*)g.A + (size_t)cur.pm * 2 * hsA + (size_t)cur.pn * g.acol * 2; const char* cB = (const char*)g.Bt + (size_t)cur.pn * 2 * hsB;
    PG8_STAGE(PG8_SB(0, 0), cB, voffB); PG8_STAGE(PG8_SB(0, 1), cB + hsB, voffB); PG8_STAGE(PG8_SA(0, 0), cA, voffA); PG8_STAGE(PG8_SA(0, 1), cA + hsA, voffA);
    if (wr == 1) PG8_BAR;
    PG8_WAIT_V(2); PG8_BAR;
    PG8_STAGE(PG8_SB(1, 0), cB + kstep, voffB); PG8_STAGE(PG8_SA(1, 0), cA + kstep, voffA); PG8_STAGE(PG8_SB(1, 1), cB + hsB + kstep, voffB);
    PG8_WAIT_V(6); PG8_BAR;
    for (;;) {
        const bool has_next = S.next(ui + 1, nxt);
        const char* nA = has_next ? (const char*)g.A + (size_t)nxt.pm * 2 * hsA + (size_t)nxt.pn * g.acol * 2 : cA; const char* nB = has_next ? (const char*)g.Bt + (size_t)nxt.pn * 2 * hsB : cB;
        for (int t = 0; t < nt; t += 2) {
            const bool last = (t == nt - 2);
            const char* a1 = cA + (size_t)(t + 1) * kstep;
            const char* a2 = last ? nA : cA + (size_t)(t + 2) * kstep; const char* b2 = last ? nB : cB + (size_t)(t + 2) * kstep;
            const char* a3 = a2 + kstep; const char* b3 = b2 + kstep;
            PG8_LDB(B0, 0, 0); PG8_LDB(B1, 0, 1); PG8_SCHED; PG8_LDA(At, 0, 0); PG8_STAGE(PG8_SA(1, 1), a1 + hsA, voffA);
            PG8_WAIT_V(8); PG8_WAIT_L(0); PG8_BAR; PG8_MMA(0, 0, At, B0); PG8_MMA(0, 1, At, B1); PG8_BAR; PG8_SCHED;
            PG8_LDA(At, 0, 1); PG8_STAGE(PG8_SB(0, 0), b2, voffB); PG8_STAGE(PG8_SB(0, 1), b2 + hsB, voffB); PG8_STAGE(PG8_SA(0, 0), a2, voffA);
            PG8_WAIT_V(8); PG8_WAIT_L(0); PG8_BAR; PG8_MMA(1, 0, At, B0); PG8_MMA(1, 1, At, B1); PG8_BAR; PG8_SCHED;
            PG8_LDB(B0, 1, 0); PG8_LDB(B1, 1, 1); PG8_SCHED; PG8_LDA(At, 1, 0); PG8_STAGE(PG8_SA(0, 1), a2 + hsA, voffA);
            PG8_WAIT_V(8); PG8_WAIT_L(0); PG8_BAR; PG8_MMA(0, 0, At, B0); PG8_MMA(0, 1, At, B1); PG8_BAR; PG8_SCHED;
            PG8_LDA(At, 1, 1); PG8_STAGE(PG8_SB(1, 0), b3, voffB); PG8_STAGE(PG8_SB(1, 1), b3 + hsB, voffB); PG8_STAGE(PG8_SA(1, 0), a3, voffA);
            PG8_WAIT_V(8); PG8_WAIT_L(0); PG8_BAR; PG8_MMA(1, 0, At, B0); PG8_MMA(1, 1, At, B1); PG8_BAR; PG8_SCHED;
        }
        if (wr == 0) PG8_BAR;
        E(acc, cur, wr, wc, fr, fq);
        if (!has_next) break;
#pragma unroll
        for (int a = 0; a < 2; ++a)
#pragma unroll
            for (int b = 0; b < 2; ++b)
#pragma unroll
                for (int m = 0; m < 4; ++m)
#pragma unroll
                    for (int n = 0; n < 2; ++n) acc[a][b][m][n] = (f32x4){0.f, 0.f, 0.f, 0.f};
        cur = nxt; cA = nA; cB = nB; ++ui;
        if (wr == 1) PG8_BAR;
    }
    PG8_WAIT_V(0);
    PG8_BAR;
#undef PG8_SA
#undef PG8_SB
#undef PG8_STAGE
#undef PG8_LDA
#undef PG8_LDB
#undef PG8_MMA
#undef PG8_WAIT_V
#undef PG8_WAIT_L
#undef PG8_BAR
#undef PG8_SCHED
}
template <class Epi>
__device__ __forceinline__ void gemm_phase2(LAS unsigned char* lds, const Gemm g, const Gemm g1, const StaticOrder& S, const Epi& E, int wid) {
    const int lane = lane_fresh(), tid = wid * 64 + lane, wr = wid >> 2, wc = wid & 3, fr = lane & 15, fq = lane >> 4;
    int K0 = g.K, K1 = g1.K; asm volatile("" : "+s"(K0), "+s"(K1));
    const int nt0 = K0 / BK, nt1 = K1 / BK;
    unsigned voffA[2], voffB[2];
#pragma unroll
    for (int i = 0; i < 2; ++i) { int R, C; stage_rc(tid * 16 + i * 8192, R, C); const int Rb = Epi::PERM ? ((R & ~31) + perm32(R & 31)) : R;
        voffA[i] = (unsigned)(R * g.lda + C) * 2u; voffB[i] = (unsigned)(Rb * g.ldb + C) * 2u; }
    const size_t kstep = (size_t)(BK * 2);
    const size_t hsA = (size_t)HALF * g.lda * 2, hsB = (size_t)HALF * g.ldb * 2;
    const unsigned ldsw = (unsigned)wid * 1024u;
    const int aoff = lds_byte(wr * 64 + fr, fq * 8), boff = lds_byte(wc * 32 + fr, fq * 8);
#define PG8_SA(b, h) (((b) * 2 + (h)) * HTB)
#define PG8_SB(b, h) ((4 + (b) * 2 + (h)) * HTB)
#define PG8_STAGE(bufoff, gbase, voff) do { _Pragma("unroll") for (int _i = 0; _i < 2; ++_i) \
        __builtin_amdgcn_global_load_lds((const unsigned*)((const char*)(gbase) + (voff)[_i]), (LAS unsigned*)(lds + (bufoff) + ldsw + _i * 8192), 16, 0, 0); } while (0)
#define PG8_LDA(dst, b, h) do { _Pragma("unroll") for (int m = 0; m < 4; ++m) _Pragma("unroll") for (int k = 0; k < 2; ++k) dst[m][k] = *(const LAS bf16x8*)(lds + PG8_SA(b, h) + aoff + m * 2048 + k * 1024); } while (0)
#define PG8_LDB(dst, b, h) do { _Pragma("unroll") for (int n = 0; n < 2; ++n) _Pragma("unroll") for (int k = 0; k < 2; ++k) dst[n][k] = *(const LAS bf16x8*)(lds + PG8_SB(b, h) + boff + n * 2048 + k * 1024); } while (0)
#define PG8_MMA(ai, bj, At, Bt) do { __builtin_amdgcn_s_setprio(1); _Pragma("unroll") for (int m = 0; m < 4; ++m) _Pragma("unroll") for (int n = 0; n < 2; ++n) _Pragma("unroll") for (int k = 0; k < 2; ++k) \
        acc[ai][bj][m][n] = __builtin_amdgcn_mfma_f32_16x16x32_bf16(Bt[n][k], At[m][k], acc[ai][bj][m][n], 0, 0, 0); __builtin_amdgcn_s_setprio(0); } while (0)
#define PG8_WAIT_V(n) asm volatile("s_waitcnt vmcnt(" #n ")" ::: "memory")
#define PG8_WAIT_L(n) asm volatile("s_waitcnt lgkmcnt(" #n ")" ::: "memory")
#define PG8_BAR __builtin_amdgcn_s_barrier()
#define PG8_SCHED __builtin_amdgcn_sched_barrier(0)
    Unit cur, nxt; int ui = 0;
    if (!S.next(0, cur)) return;
#define SEG_A(u_, sg_) ((const char*)((sg_) ? g1.A : g.A) + (size_t)(u_).pm * 2 * hsA)
#define SEG_B(u_, sg_) ((const char*)((sg_) ? g1.Bt : g.Bt) + (size_t)(u_).pn * 2 * hsB)
    f32x4 acc[2][2][4][2];
#pragma unroll
    for (int a = 0; a < 2; ++a)
#pragma unroll
        for (int b = 0; b < 2; ++b)
#pragma unroll
            for (int m = 0; m < 4; ++m)
#pragma unroll
                for (int n = 0; n < 2; ++n) acc[a][b][m][n] = (f32x4){0.f, 0.f, 0.f, 0.f};
    bf16x8 At[4][2], B0[2][2], B1[2][2];
    const char* cA = SEG_A(cur, 0); const char* cB = SEG_B(cur, 0);
    PG8_STAGE(PG8_SB(0, 0), cB, voffB); PG8_STAGE(PG8_SB(0, 1), cB + hsB, voffB); PG8_STAGE(PG8_SA(0, 0), cA, voffA); PG8_STAGE(PG8_SA(0, 1), cA + hsA, voffA);
    if (wr == 1) PG8_BAR;
    PG8_WAIT_V(2); PG8_BAR;
    PG8_STAGE(PG8_SB(1, 0), cB + kstep, voffB); PG8_STAGE(PG8_SA(1, 0), cA + kstep, voffA); PG8_STAGE(PG8_SB(1, 1), cB + hsB + kstep, voffB);
    PG8_WAIT_V(6); PG8_BAR;
    for (;;) {
        const int seg = ui & 1, nt = seg ? nt1 : nt0;
        bool has_next = true; nxt = cur; if (seg) has_next = S.next((ui + 1) >> 1, nxt);
        const char* nA = has_next ? SEG_A(nxt, seg ^ 1) : cA; const char* nB = has_next ? SEG_B(nxt, seg ^ 1) : cB;
        for (int t = 0; t < nt; t += 2) {
            const bool last = (t == nt - 2);
            const char* a1 = cA + (size_t)(t + 1) * kstep;
            const char* a2 = last ? nA : cA + (size_t)(t + 2) * kstep; const char* b2 = last ? nB : cB + (size_t)(t + 2) * kstep;
            const char* a3 = a2 + kstep; const char* b3 = b2 + kstep;
            PG8_LDB(B0, 0, 0); PG8_LDB(B1, 0, 1); PG8_SCHED; PG8_LDA(At, 0, 0); PG8_STAGE(PG8_SA(1, 1), a1 + hsA, voffA);
            PG8_WAIT_V(8); PG8_WAIT_L(0); PG8_BAR; PG8_MMA(0, 0, At, B0); PG8_MMA(0, 1, At, B1); PG8_BAR; PG8_SCHED;
            PG8_LDA(At, 0, 1); PG8_STAGE(PG8_SB(0, 0), b2, voffB); PG8_STAGE(PG8_SB(0, 1), b2 + hsB, voffB); PG8_STAGE(PG8_SA(0, 0), a2, voffA);
            PG8_WAIT_V(8); PG8_WAIT_L(0); PG8_BAR; PG8_MMA(1, 0, At, B0); PG8_MMA(1, 1, At, B1); PG8_BAR; PG8_SCHED;
            PG8_LDB(B0, 1, 0); PG8_LDB(B1, 1, 1); PG8_SCHED; PG8_LDA(At, 1, 0); PG8_STAGE(PG8_SA(0, 1), a2 + hsA, voffA);
            PG8_WAIT_V(8); PG8_WAIT_L(0); PG8_BAR; PG8_MMA(0, 0, At, B0); PG8_MMA(0, 1, At, B1); PG8_BAR; PG8_SCHED;
            PG8_LDA(At, 1, 1); PG8_STAGE(PG8_SB(1, 0), b3, voffB); PG8_STAGE(PG8_SB(1, 1), b3 + hsB, voffB); PG8_STAGE(PG8_SA(1, 0), a3, voffA);
            PG8_WAIT_V(8); PG8_WAIT_L(0); PG8_BAR; PG8_MMA(1, 0, At, B0); PG8_MMA(1, 1, At, B1); PG8_BAR; PG8_SCHED;
        }
        if (wr == 0) PG8_BAR;
        if (seg == 0) E.mid(acc, cur, wr, wc, fr, fq); else E(acc, cur, wr, wc, fr, fq);
        if (!has_next) break;
        if (seg)
#pragma unroll
        for (int a = 0; a < 2; ++a)
#pragma unroll
            for (int b = 0; b < 2; ++b)
#pragma unroll
                for (int m = 0; m < 4; ++m)
#pragma unroll
                    for (int n = 0; n < 2; ++n) acc[a][b][m][n] = (f32x4){0.f, 0.f, 0.f, 0.f};
        cur = nxt; cA = nA; cB = nB; ++ui;
        if (wr == 1) PG8_BAR;
    }
    PG8_WAIT_V(0);
    PG8_BAR;
#undef SEG_A
#undef SEG_B
#undef PG8_SA
#undef PG8_SB
#undef PG8_STAGE
#undef PG8_LDA
#undef PG8_LDB
#undef PG8_MMA
#undef PG8_WAIT_V
#undef PG8_WAIT_L
#undef PG8_BAR
#undef PG8_SCHED
}
}
using pg8::Unit;

#define ROW_OF(u, ai, wr, m, fr) ((u).pm * 256 + (ai) * 128 + (wr) * 64 + (m) * 16 + (fr))

struct EpiIn {
    static constexpr bool PERM = true;
    bf16_t* Q; bf16_t* Kb; bf16_t* Vb; float* U; unsigned short* SG; const float* COS; const float* SIN; float* out;
    __device__ __forceinline__ void operator()(const f32x4 (&acc)[2][2][4][2], const Unit& u, int wr, int wc, int fr, int fq) const {
        const int pn = u.pn;
        if (pn <= 8) {
            const float sc = pn < 8 ? QSCALE : 1.f;
            bf16_t* dst = pn < 8 ? Q : Kb; const int ld = pn < 8 ? DM : KVD; const int cb = (pn < 8 ? pn * 256 : 0) + 64 * wc + 8 * fq;
#pragma unroll
            for (int ai = 0; ai < 2; ++ai) {
                f32x4 tc0[4], tc1[4], ts0[4], ts1[4];
#pragma unroll
                for (int m = 0; m < 4; ++m) { const int r = ROW_OF(u, ai, wr, m, fr); const int pos = r < SEQ ? r : SEQ;
                    tc0[m] = *(const f32x4*)(COS + pos * 32 + 8 * fq); tc1[m] = *(const f32x4*)(COS + pos * 32 + 8 * fq + 4);
                    ts0[m] = *(const f32x4*)(SIN + pos * 32 + 8 * fq); ts1[m] = *(const f32x4*)(SIN + pos * 32 + 8 * fq + 4); }
#pragma unroll
                for (int m = 0; m < 4; ++m) {
                    const int r = ROW_OF(u, ai, wr, m, fr);
                    const f32x4 c0 = tc0[m], c1 = tc1[m], s0 = ts0[m], s1 = ts1[m];
                    const f32x4 a0 = acc[ai][0][m][0], a1 = acc[ai][0][m][1], b0 = acc[ai][1][m][0], b1 = acc[ai][1][m][1];
                    const f32x4 o10 = (a0 * c0 - b0 * s0) * sc, o11 = (a1 * c1 - b1 * s1) * sc, o20 = (b0 * c0 + a0 * s0) * sc, o21 = (b1 * c1 + a1 * s1) * sc;
                    u32x4 w1, w2; w1.x = cvtpk(o10[0], o10[1]); w1.y = cvtpk(o10[2], o10[3]); w1.z = cvtpk(o11[0], o11[1]); w1.w = cvtpk(o11[2], o11[3]);
                    w2.x = cvtpk(o20[0], o20[1]); w2.y = cvtpk(o20[2], o20[3]); w2.z = cvtpk(o21[0], o21[1]); w2.w = cvtpk(o21[2], o21[3]);
                    *(u32x4*)(dst + (size_t)r * ld + cb) = w1; *(u32x4*)(dst + (size_t)r * ld + cb + 32) = w2;
                    if (pn == 8) {
                        float* o = nullptr;
                        if (r >= SEQ - 128 && r < SEQ) o = out + O_KP + (size_t)(r - (SEQ - 128)) * 256 + cb;
                        else if (r >= SEQ && r < MR) o = out + O_KS + ((size_t)(r - SEQ) * 128 + 127) * 256 + cb;
                        if (o) { *(f32x4*)o = o10; *(f32x4*)(o + 4) = o11; *(f32x4*)(o + 32) = o20; *(f32x4*)(o + 36) = o21; }
                    }
                }
            }
        } else if (pn == 9) {
#pragma unroll
            for (int ai = 0; ai < 2; ++ai)
#pragma unroll
                for (int m = 0; m < 4; ++m) {
                    const int r = ROW_OF(u, ai, wr, m, fr);
                    float* o = nullptr;
                    if (r >= SEQ - 128 && r < SEQ) o = out + O_VP + (size_t)(r - (SEQ - 128)) * 256;
                    else if (r >= SEQ && r < MR) o = out + O_VS + ((size_t)(r - SEQ) * 128 + 127) * 256;
#pragma unroll
                    for (int bj = 0; bj < 2; ++bj) { const int c = 128 * bj + 32 * wc + 8 * fq; const f32x4 v0 = acc[ai][bj][m][0], v1 = acc[ai][bj][m][1];
                        u32x4 w; w.x = cvtpk(v0[0], v0[1]); w.y = cvtpk(v0[2], v0[3]); w.z = cvtpk(v1[0], v1[1]); w.w = cvtpk(v1[2], v1[3]);
                        *(u32x4*)(Vb + (size_t)r * KVD + c) = w;
                        if (o) { *(f32x4*)(o + c) = v0; *(f32x4*)(o + c + 4) = v1; } }
                }
        } else if (pn < 14) {
#pragma unroll
            for (int ai = 0; ai < 2; ++ai)
#pragma unroll
                for (int m = 0; m < 4; ++m) {
                    const int r = ROW_OF(u, ai, wr, m, fr);
                    float* o = nullptr;
                    if (r >= SEQ - 15 && r < SEQ) o = out + O_PP + (size_t)(r - (SEQ - 15)) * PW;
                    else if (r >= SEQ && r < MR) o = out + O_PS + ((size_t)(r - SEQ) * 15 + 14) * PW;
#pragma unroll
                    for (int bj = 0; bj < 2; ++bj) { const int c = (pn - 10) * 256 + 128 * bj + 32 * wc + 8 * fq; const f32x4 v0 = acc[ai][bj][m][0], v1 = acc[ai][bj][m][1];
                        { u32x4 w; w.x = cvtpk(v0[0], v0[1]); w.y = cvtpk(v0[2], v0[3]); w.z = cvtpk(v1[0], v1[1]); w.w = cvtpk(v1[2], v1[3]); *(u32x4*)((bf16_t*)U + (size_t)r * PW + c) = w; }
                        if (o) { *(f32x4*)(o + c) = v0; *(f32x4*)(o + c + 4) = v1; } }
                }
        } else {
#pragma unroll
            for (int ai = 0; ai < 2; ++ai)
#pragma unroll
                for (int m = 0; m < 4; ++m) {
                    const int r = ROW_OF(u, ai, wr, m, fr);
                    {
                      const int c = (pn - 14) * 128 + 32 * wc + 8 * fq; float qv[8], sv[8];
#pragma unroll
                      for (int e = 0; e < 8; ++e) { const float gpv = acc[ai][0][m][e >> 2][e & 3], gav = acc[ai][1][m][e >> 2][e & 3];
                          const float ep = __builtin_amdgcn_exp2f(-1.4426950408889634f * gpv), ea = __builtin_amdgcn_exp2f(-1.4426950408889634f * gav);
                          const float sgp = __builtin_amdgcn_rcpf(1.f + ep); const float isga = fminf(1.f + ea, 16129.0f);
                          qv[e] = sgp * isga; sv[e] = fmaxf(__builtin_amdgcn_rcpf(1.f + ea), 6.2e-5f); }
                      u32x4 wq, ws_; wq.x = pkh(qv[0], qv[1]); wq.y = pkh(qv[2], qv[3]); wq.z = pkh(qv[4], qv[5]); wq.w = pkh(qv[6], qv[7]);
                      ws_.x = pkh(sv[0], sv[1]); ws_.y = pkh(sv[2], sv[3]); ws_.z = pkh(sv[4], sv[5]); ws_.w = pkh(sv[6], sv[7]);
                      *(u32x4*)(SG + (size_t)r * 4096 + c) = wq; *(u32x4*)(SG + (size_t)r * 4096 + 2048 + c) = ws_; }
                }
        }
    }
};
struct EpiMix {
    static constexpr bool PERM = true;
    bf16_t* PY; const float* scale;
    __device__ __forceinline__ void operator()(const f32x4 (&acc)[2][2][4][2], const Unit& u, int wr, int wc, int fr, int fq) const {
#pragma unroll
        for (int bj = 0; bj < 2; ++bj) { const int c = u.pn * 256 + 128 * bj + 32 * wc + 8 * fq; const f32x4 s0 = *(const f32x4*)(scale + c), s1 = *(const f32x4*)(scale + c + 4);
#pragma unroll
            for (int ai = 0; ai < 2; ++ai)
#pragma unroll
                for (int m = 0; m < 4; ++m) { const int r = ROW_OF(u, ai, wr, m, fr); const f32x4 v0 = acc[ai][bj][m][0] * s0, v1 = acc[ai][bj][m][1] * s1;
                    u32x4 w; w.x = cvtpk(v0[0], v0[1]); w.y = cvtpk(v0[2], v0[3]); w.z = cvtpk(v1[0], v1[1]); w.w = cvtpk(v1[2], v1[3]);
                    *(u32x4*)(PY + (size_t)r * PW + c) = w; } }
    }
};
struct EpiWeff {
    static constexpr bool PERM = true;
    bf16_t* W;
    __device__ __forceinline__ void operator()(const f32x4 (&acc)[2][2][4][2], const Unit& u, int wr, int wc, int fr, int fq) const {
#pragma unroll
        for (int bj = 0; bj < 2; ++bj) { const int c = u.pn * 256 + 128 * bj + 32 * wc + 8 * fq;
#pragma unroll
            for (int ai = 0; ai < 2; ++ai)
#pragma unroll
                for (int m = 0; m < 4; ++m) { const int r = ROW_OF(u, ai, wr, m, fr); const f32x4 v0 = acc[ai][bj][m][0], v1 = acc[ai][bj][m][1];
                    u32x4 w; w.x = cvtpk(v0[0], v0[1]); w.y = cvtpk(v0[2], v0[3]); w.z = cvtpk(v1[0], v1[1]); w.w = cvtpk(v1[2], v1[3]);
                    *(u32x4*)(W + (size_t)r * DM + c) = w; } }
    }
};
struct EpiBrA {
    static constexpr bool PERM = false;
    float* T1; const unsigned short* SG;
    __device__ __forceinline__ void operator()(const f32x4 (&acc)[2][2][4][2], const Unit& u, int wr, int wc, int fr, int fq) const {
#pragma unroll
        for (int ai = 0; ai < 2; ++ai)
#pragma unroll
            for (int m = 0; m < 4; ++m) { const int r = ROW_OF(u, ai, wr, m, fr); if (r < MR) {
#pragma unroll
                for (int bj = 0; bj < 2; ++bj)
#pragma unroll
                    for (int n = 0; n < 2; ++n) { const int c = u.pn * 256 + 128 * bj + 32 * wc + 16 * n + 4 * fq; const u32x2 gw = *(const u32x2*)(SG + (size_t)r * 4096 + c);
                        const f32x4 gt = {hlo(gw.x), hhi(gw.x), hlo(gw.y), hhi(gw.y)}; *(f32x4*)(T1 + (size_t)r * DM + c) = acc[ai][bj][m][n] * gt; } } }
    }
};
struct EpiBrB {
    static constexpr bool PERM = false;
    const float* T1; const unsigned short* SG; bf16_t* MG;
    __device__ __forceinline__ void operator()(const f32x4 (&acc)[2][2][4][2], const Unit& u, int wr, int wc, int fr, int fq) const {
#pragma unroll
        for (int ai = 0; ai < 2; ++ai)
#pragma unroll
            for (int m = 0; m < 4; ++m) { const int r = ROW_OF(u, ai, wr, m, fr);
#pragma unroll
                for (int bj = 0; bj < 2; ++bj)
#pragma unroll
                    for (int n = 0; n < 2; ++n) { const int c = u.pn * 256 + 128 * bj + 32 * wc + 16 * n + 4 * fq; f32x4 o = {0.f, 0.f, 0.f, 0.f};
                        if (r < MR) { const u32x2 gw = *(const u32x2*)(SG + (size_t)r * 4096 + 2048 + c); const f32x4 gt = {hlo(gw.x), hhi(gw.x), hlo(gw.y), hhi(gw.y)};
                            o = *(const f32x4*)(T1 + (size_t)r * DM + c) + acc[ai][bj][m][n] * gt; }
                        u32x2 w; w.x = cvtpk(o[0], o[1]); w.y = cvtpk(o[2], o[3]); *(u32x2*)(MG + (size_t)r * DM + c) = w; } }
    }
};
struct EpiBr {
    static constexpr bool PERM = false;
    const unsigned short* SG; bf16_t* MG;
    __device__ __forceinline__ void mid(f32x4 (&acc)[2][2][4][2], const Unit& u, int wr, int wc, int fr, int fq) const {
        unsigned o0 = (unsigned)((u.pm * 256 + wr * 64 + fr) * 4096 + u.pn * 256 + 32 * wc + 4 * fq) * 2u; asm volatile("" : "+v"(o0)); const char* sb = (const char*)SG;
#pragma unroll
        for (int ai = 0; ai < 2; ++ai) {
            u32x2 gq[4][2][2];
#pragma unroll
            for (int m = 0; m < 4; ++m)
#pragma unroll
                for (int bj = 0; bj < 2; ++bj)
#pragma unroll
                    for (int n = 0; n < 2; ++n) { const unsigned o = o0 + (unsigned)(((ai * 128 + m * 16) * 4096 + 128 * bj + 16 * n) * 2); gq[m][bj][n] = *(const u32x2*)(sb + o); }
#pragma unroll
            for (int m = 0; m < 4; ++m)
#pragma unroll
                for (int bj = 0; bj < 2; ++bj)
#pragma unroll
                    for (int n = 0; n < 2; ++n) { const u32x2 p_ = gq[m][bj][n]; const f32x4 rt = {hlo(p_.x), hhi(p_.x), hlo(p_.y), hhi(p_.y)}; acc[ai][bj][m][n] = acc[ai][bj][m][n] * rt; }
            asm volatile("" : "+v"(acc[ai][0][0][0]), "+v"(acc[ai][0][0][1]), "+v"(acc[ai][1][0][0]), "+v"(acc[ai][1][0][1]), "+v"(acc[ai][0][1][0]), "+v"(acc[ai][0][1][1]), "+v"(acc[ai][1][1][0]), "+v"(acc[ai][1][1][1]),
                             "+v"(acc[ai][0][2][0]), "+v"(acc[ai][0][2][1]), "+v"(acc[ai][1][2][0]), "+v"(acc[ai][1][2][1]), "+v"(acc[ai][0][3][0]), "+v"(acc[ai][0][3][1]), "+v"(acc[ai][1][3][0]), "+v"(acc[ai][1][3][1]) :: "memory"); }
    }
    __device__ __forceinline__ void operator()(f32x4 (&acc)[2][2][4][2], const Unit& u, int wr, int wc, int fr, int fq) const {
        unsigned o0 = (unsigned)((u.pm * 256 + wr * 64 + fr) * 4096 + u.pn * 256 + 32 * wc + 4 * fq) * 2u; asm volatile("" : "+v"(o0)); const char* sb = (const char*)SG; char* mb = (char*)MG;
#pragma unroll
        for (int ai = 0; ai < 2; ++ai) {
            u32x2 ga[4][2][2];
#pragma unroll
            for (int m = 0; m < 4; ++m)
#pragma unroll
                for (int bj = 0; bj < 2; ++bj)
#pragma unroll
                    for (int n = 0; n < 2; ++n) { const unsigned o = o0 + (unsigned)(((ai * 128 + m * 16) * 4096 + 128 * bj + 16 * n) * 2); ga[m][bj][n] = *(const u32x2*)(sb + o + 4096); }
#pragma unroll
            for (int m = 0; m < 4; ++m)
#pragma unroll
                for (int bj = 0; bj < 2; ++bj)
#pragma unroll
                    for (int n = 0; n < 2; ++n) { const u32x2 q_ = ga[m][bj][n];
                        const f32x4 q = {fmaxf(hlo(q_.x), 6.2e-5f), fmaxf(hhi(q_.x), 6.2e-5f), fmaxf(hlo(q_.y), 6.2e-5f), fmaxf(hhi(q_.y), 6.2e-5f)};
                        const f32x4 v = acc[ai][bj][m][n] * q; u32x2 w; w.x = cvtpk(v[0], v[1]); w.y = cvtpk(v[2], v[3]);
                        const unsigned row = (unsigned)(u.pm * 256 + wr * 64 + fr + ai * 128 + m * 16), col = (unsigned)(u.pn * 256 + 32 * wc + 4 * fq + 128 * bj + 16 * n);
                        *(u32x2*)(mb + ((size_t)row * DM + col) * 2) = w; }
            asm volatile("" ::: "memory"); }
    }
};
struct EpiOut {
    static constexpr bool PERM = false;
    const float* xp; const float* xs; float* H1;
    __device__ __forceinline__ void operator()(const f32x4 (&acc)[2][2][4][2], const Unit& u, int wr, int wc, int fr, int fq) const {
#pragma unroll
        for (int ai = 0; ai < 2; ++ai)
#pragma unroll
            for (int m = 0; m < 4; ++m) { const int r = ROW_OF(u, ai, wr, m, fr); if (r < MR) { const float* xr = r < SEQ ? xp + (size_t)r * DM : xs + (size_t)(r - SEQ) * DM;
#pragma unroll
                for (int bj = 0; bj < 2; ++bj)
#pragma unroll
                    for (int n = 0; n < 2; ++n) { const int c = u.pn * 256 + 128 * bj + 32 * wc + 16 * n + 4 * fq;
                        *(f32x4*)(H1 + (size_t)r * DM + c) = *(const f32x4*)(xr + c) * ALPHA + acc[ai][bj][m][n]; } } }
    }
};

__device__ __forceinline__ void ln_tile(f32x4 (&v)[2][2][4][2], const Unit& u, int wr, int wc, int fr, int fq, LAS unsigned char* lx, float* rowstat, unsigned* cnt, unsigned want, const float* gam, const float* bet) {
    LAS f32x2* P = (LAS f32x2*)lx; LAS f32x2* S = (LAS f32x2*)(lx + 8192);
    const int tid = (wr * 4 + wc) * 64 + fq * 16 + fr;
#pragma unroll
    for (int ai = 0; ai < 2; ++ai)
#pragma unroll
        for (int m = 0; m < 4; ++m) { float s = 0.f, q = 0.f;
#pragma unroll
            for (int bj = 0; bj < 2; ++bj)
#pragma unroll
                for (int n = 0; n < 2; ++n) { const f32x4 x = v[ai][bj][m][n]; s += (x[0] + x[1]) + (x[2] + x[3]); q += (x[0] * x[0] + x[1] * x[1]) + (x[2] * x[2] + x[3] * x[3]); }
            s += __shfl_xor(s, 16); s += __shfl_xor(s, 32); q += __shfl_xor(q, 16); q += __shfl_xor(q, 32);
            if (fq == 0) P[(ai * 128 + wr * 64 + m * 16 + fr) * 4 + wc] = (f32x2){s, q}; }
    __syncthreads();
    if (tid < 256) { const f32x2 a = P[tid * 4 + 0], b = P[tid * 4 + 1], c = P[tid * 4 + 2], d = P[tid * 4 + 3];
        float* rs = rowstat + (size_t)(u.pm * 256 + tid) * 2;
        (void)__hip_atomic_fetch_add(rs, (a[0] + b[0]) + (c[0] + d[0]), __ATOMIC_RELAXED, __HIP_MEMORY_SCOPE_AGENT);
        (void)__hip_atomic_fetch_add(rs + 1, (a[1] + b[1]) + (c[1] + d[1]), __ATOMIC_RELAXED, __HIP_MEMORY_SCOPE_AGENT); }
    asm volatile("s_waitcnt vmcnt(0)" ::: "memory");
    __syncthreads();
    if (tid == 0) { (void)__hip_atomic_fetch_add(cnt, 1u, __ATOMIC_RELAXED, __HIP_MEMORY_SCOPE_AGENT);
        unsigned sp = 0; while (__hip_atomic_load(cnt, __ATOMIC_RELAXED, __HIP_MEMORY_SCOPE_AGENT) < want) { __builtin_amdgcn_s_sleep(1); if (++sp > (1u << 22)) break; }
        asm volatile("s_waitcnt vmcnt(0)" ::: "memory"); }
    __syncthreads();
    if (tid < 256) { float* rs = rowstat + (size_t)(u.pm * 256 + tid) * 2;
        const float sm = __hip_atomic_load(rs, __ATOMIC_RELAXED, __HIP_MEMORY_SCOPE_AGENT), sq = __hip_atomic_load(rs + 1, __ATOMIC_RELAXED, __HIP_MEMORY_SCOPE_AGENT);
        const float mean = sm * (1.f / DM), var = sq * (1.f / DM) - mean * mean; S[tid] = (f32x2){mean, 1.f / sqrtf(fmaxf(var, 0.f) + LN_EPS)}; }
    __syncthreads();
#pragma unroll
    for (int bj = 0; bj < 2; ++bj)
#pragma unroll
        for (int n = 0; n < 2; ++n) { const int c = u.pn * 256 + 128 * bj + 32 * wc + 16 * n + 4 * fq; const f32x4 g = *(const f32x4*)(gam + c), b = *(const f32x4*)(bet + c);
#pragma unroll
            for (int ai = 0; ai < 2; ++ai)
#pragma unroll
                for (int m = 0; m < 4; ++m) { const f32x2 st = S[ai * 128 + wr * 64 + m * 16 + fr]; v[ai][bj][m][n] = (v[ai][bj][m][n] - st[0]) * st[1] * g + b; } }
}
__device__ __forceinline__ unsigned tile_off0(const Unit& u, int wr, int wc, int fr, int fq) { unsigned o = (unsigned)((u.pm * 256 + wr * 64 + fr) * DM + u.pn * 256 + 32 * wc + 4 * fq) * 4u; asm volatile("" : "+v"(o)); return o; }
#define TILE_OFF(o0, ai, m, bj, n) ((o0) + (unsigned)(((ai) * 128 + (m) * 16) * DM * 4 + (128 * (bj) + 16 * (n)) * 4))
struct EpiOutLN {
    static constexpr bool PERM = false;
    const float* xp; float* Y; bf16_t* XB; LAS unsigned char* lx; float* rowstat; unsigned* cnt; const float* gam; const float* bet;
    __device__ __forceinline__ void operator()(f32x4 (&acc)[2][2][4][2], const Unit& u, int wr, int wc, int fr, int fq) const {
        { const unsigned o0 = tile_off0(u, wr, wc, fr, fq); const char* xb = (const char*)xp;
#pragma unroll
          for (int ai = 0; ai < 2; ++ai)
#pragma unroll
            for (int m = 0; m < 4; ++m) {
#pragma unroll
                for (int bj = 0; bj < 2; ++bj)
#pragma unroll
                    for (int n = 0; n < 2; ++n) acc[ai][bj][m][n] = __builtin_nontemporal_load((const f32x4*)(xb + TILE_OFF(o0, ai, m, bj, n))) * ALPHA + acc[ai][bj][m][n];
                if (m == 3) asm volatile("" : "+v"(acc[ai][0][0][0]), "+v"(acc[ai][0][0][1]), "+v"(acc[ai][1][0][0]), "+v"(acc[ai][1][0][1]), "+v"(acc[ai][0][1][0]), "+v"(acc[ai][0][1][1]), "+v"(acc[ai][1][1][0]), "+v"(acc[ai][1][1][1]),
                                               "+v"(acc[ai][0][2][0]), "+v"(acc[ai][0][2][1]), "+v"(acc[ai][1][2][0]), "+v"(acc[ai][1][2][1]), "+v"(acc[ai][0][3][0]), "+v"(acc[ai][0][3][1]), "+v"(acc[ai][1][3][0]), "+v"(acc[ai][1][3][1]) :: "memory"); } }
        ln_tile(acc, u, wr, wc, fr, fq, lx, rowstat, cnt + 64 * u.pm, 8u, gam, bet);
        { const unsigned o0 = tile_off0(u, wr, wc, fr, fq); char* bb = (char*)XB;
#pragma unroll
          for (int ai = 0; ai < 2; ++ai)
#pragma unroll
            for (int m = 0; m < 4; ++m) {
#pragma unroll
                for (int bj = 0; bj < 2; ++bj)
#pragma unroll
                    for (int n = 0; n < 2; ++n) { const unsigned o = TILE_OFF(o0, ai, m, bj, n); const f32x4 v = acc[ai][bj][m][n];
                        u32x2 w; w.x = cvtpk(v[0], v[1]); w.y = cvtpk(v[2], v[3]); *(u32x2*)(bb + (o >> 1)) = w; }
                asm volatile("" ::: "memory"); } }
    }
};
struct EpiDownLN {
    static constexpr bool PERM = false;
    float* Y; const bf16_t* XB; LAS unsigned char* lx; float* rowstat; unsigned* cnt; const float* gam; const float* bet;
    __device__ __forceinline__ void operator()(f32x4 (&acc)[2][2][4][2], const Unit& u, int wr, int wc, int fr, int fq) const {
        { const unsigned o0 = tile_off0(u, wr, wc, fr, fq); const char* xb = (const char*)XB;
#pragma unroll
          for (int ai = 0; ai < 2; ++ai)
#pragma unroll
            for (int m = 0; m < 4; ++m) {
#pragma unroll
                for (int bj = 0; bj < 2; ++bj)
#pragma unroll
                    for (int n = 0; n < 2; ++n) { const u32x2 xw = __builtin_nontemporal_load((const u32x2*)(xb + (TILE_OFF(o0, ai, m, bj, n) >> 1))); const f32x4 xv = {bflo(xw.x), bfhi(xw.x), bflo(xw.y), bfhi(xw.y)}; acc[ai][bj][m][n] = xv * ALPHA + acc[ai][bj][m][n]; }
                if (m == 3) asm volatile("" : "+v"(acc[ai][0][0][0]), "+v"(acc[ai][0][0][1]), "+v"(acc[ai][1][0][0]), "+v"(acc[ai][1][0][1]), "+v"(acc[ai][0][1][0]), "+v"(acc[ai][0][1][1]), "+v"(acc[ai][1][1][0]), "+v"(acc[ai][1][1][1]),
                                               "+v"(acc[ai][0][2][0]), "+v"(acc[ai][0][2][1]), "+v"(acc[ai][1][2][0]), "+v"(acc[ai][1][2][1]), "+v"(acc[ai][0][3][0]), "+v"(acc[ai][0][3][1]), "+v"(acc[ai][1][3][0]), "+v"(acc[ai][1][3][1]) :: "memory"); } }
        ln_tile(acc, u, wr, wc, fr, fq, lx, rowstat, cnt + 64 * u.pm, 8u, gam, bet);
        { const unsigned o0 = tile_off0(u, wr, wc, fr, fq); char* yb = (char*)Y;
#pragma unroll
          for (int ai = 0; ai < 2; ++ai)
#pragma unroll
            for (int m = 0; m < 4; ++m) {
#pragma unroll
                for (int bj = 0; bj < 2; ++bj)
#pragma unroll
                    for (int n = 0; n < 2; ++n) __builtin_nontemporal_store(acc[ai][bj][m][n], (f32x4*)(yb + TILE_OFF(o0, ai, m, bj, n)));
                asm volatile("" ::: "memory"); } }
    }
};
__device__ __forceinline__ f32x2 ln_thin(f32x2 h, int r, int tid, float* rowstat, unsigned* cnt) {
    float s = h[0] + h[1], q = h[0] * h[0] + h[1] * h[1];
#pragma unroll
    for (int o = 1; o < 16; o <<= 1) { s += __shfl_xor(s, o); q += __shfl_xor(q, o); }
    if ((tid & 15) == 0) { (void)__hip_atomic_fetch_add(rowstat + (size_t)(r - SEQ) * 32, s, __ATOMIC_RELAXED, __HIP_MEMORY_SCOPE_AGENT); (void)__hip_atomic_fetch_add(rowstat + (size_t)(r - SEQ) * 32 + 1, q, __ATOMIC_RELAXED, __HIP_MEMORY_SCOPE_AGENT); }
    asm volatile("s_waitcnt vmcnt(0)" ::: "memory");
    __syncthreads();
    if (tid == 0) { (void)__hip_atomic_fetch_add(cnt, 1u, __ATOMIC_RELAXED, __HIP_MEMORY_SCOPE_AGENT);
        unsigned sp = 0; while (__hip_atomic_load(cnt, __ATOMIC_RELAXED, __HIP_MEMORY_SCOPE_AGENT) < 64u) { __builtin_amdgcn_s_sleep(1); if (++sp > (1u << 22)) break; }
        asm volatile("s_waitcnt vmcnt(0)" ::: "memory"); }
    __syncthreads();
    const float sm = __hip_atomic_load(rowstat + (size_t)(r - SEQ) * 32, __ATOMIC_RELAXED, __HIP_MEMORY_SCOPE_AGENT), sq = __hip_atomic_load(rowstat + (size_t)(r - SEQ) * 32 + 1, __ATOMIC_RELAXED, __HIP_MEMORY_SCOPE_AGENT);
    const float mean = sm * (1.f / DM), var = sq * (1.f / DM) - mean * mean, rstd = 1.f / sqrtf(fmaxf(var, 0.f) + LN_EPS);
    return (h - mean) * rstd;
}
struct EpiGU {
    static constexpr bool PERM = true;
    bf16_t* GU; float* out;
    __device__ __forceinline__ void operator()(const f32x4 (&acc)[2][2][4][2], const Unit& u, int wr, int wc, int fr, int fq) const {
#pragma unroll
        for (int ai = 0; ai < 2; ++ai)
#pragma unroll
            for (int m = 0; m < 4; ++m) { const int r = ROW_OF(u, ai, wr, m, fr);
                float* o = nullptr;
                if (u.pn < 22) { if (r >= SEQ - 2 && r < SEQ) o = out + O_CP + (size_t)(r - (SEQ - 2)) * FF; else if (r >= SEQ && r < MR) o = out + O_CS + ((size_t)(r - SEQ) * 2 + 1) * FF; }
#pragma unroll
                for (int bj = 0; bj < 2; ++bj) { const int c = u.pn * 256 + 128 * bj + 32 * wc + 8 * fq; const f32x4 v0 = acc[ai][bj][m][0], v1 = acc[ai][bj][m][1];
                    u32x4 w; w.x = cvtpk(v0[0], v0[1]); w.y = cvtpk(v0[2], v0[3]); w.z = cvtpk(v1[0], v1[1]); w.w = cvtpk(v1[2], v1[3]);
                    *(u32x4*)((u.pn < 22 ? GU + (size_t)r * FF + c : GU + (size_t)MP * FF + (size_t)r * FF + (c - FF))) = w;
                    if (o) { *(f32x4*)(o + c) = v0; *(f32x4*)(o + c + 4) = v1; } } }
    }
};
struct EpiDown {
    static constexpr bool PERM = false;
    float* Y;
    __device__ __forceinline__ void operator()(const f32x4 (&acc)[2][2][4][2], const Unit& u, int wr, int wc, int fr, int fq) const {
#pragma unroll
        for (int ai = 0; ai < 2; ++ai)
#pragma unroll
            for (int m = 0; m < 4; ++m) { const int r = ROW_OF(u, ai, wr, m, fr); if (r < MR) {
#pragma unroll
                for (int bj = 0; bj < 2; ++bj)
#pragma unroll
                    for (int n = 0; n < 2; ++n) { const int c = u.pn * 256 + 128 * bj + 32 * wc + 16 * n + 4 * fq; float* p = Y + (size_t)r * DM + c;
                        *(f32x4*)p = *(const f32x4*)p * ALPHA + acc[ai][bj][m][n]; } } }
    }
};

__device__ __forceinline__ int map_in_row(int c) {
    if (c >= 3584) { const int ga = c >= 5632, g = c - (ga ? 5632 : 3584); return (14 + (g >> 7)) * 256 + 128 * ga + (g & 127); }
    if (c >= 2304) return c;
    const int t = c & ~255, l = c & 255; return t + 128 * ((l >> 5) & 1) + 32 * (l >> 6) + (l & 31);
}
template <bool MAPIN>
__device__ __forceinline__ void transpose_item(const float* W, int N, bf16_t* WT, int K, int row_off, int k0, int n0, LAS float* scr, int lane) {
    const int kr = lane >> 4, nc = (lane & 15) * 4;
    f32x4 v[16];
#pragma unroll
    for (int i = 0; i < 16; ++i) v[i] = *(const f32x4*)(W + (size_t)(k0 + 4 * i + kr) * N + n0 + nc);
#pragma unroll
    for (int i = 0; i < 16; ++i) { LAS float* s = scr + (4 * i + kr) * 65 + nc; s[0] = v[i][0]; s[1] = v[i][1]; s[2] = v[i][2]; s[3] = v[i][3]; }
    asm volatile("s_waitcnt lgkmcnt(0)" ::: "memory");
    const int c = lane & 7;
#pragma unroll
    for (int j = 0; j < 8; ++j) { const int n = (lane >> 3) + 8 * j; const LAS float* s = scr + (8 * c) * 65 + n;
        u32x4 o; o.x = cvtpk(s[0], s[65]); o.y = cvtpk(s[2 * 65], s[3 * 65]); o.z = cvtpk(s[4 * 65], s[5 * 65]); o.w = cvtpk(s[6 * 65], s[7 * 65]);
        const int orow = MAPIN ? map_in_row(n0 + n) : (n0 + n);
        *(u32x4*)(WT + (size_t)(row_off + orow) * K + k0 + 8 * c) = o; }
    asm volatile("s_waitcnt lgkmcnt(0)" ::: "memory");
}

struct ConvPtrs { const float *w_in, *w_mix, *w_ab, *w_pb, *w_out, *w_gate, *w_up, *w_down; bf16_t *WinT, *WmixT, *WabT, *WpbT, *WoT, *WguT, *WdT; };
constexpr int CI_IN = 32 * 120, CI_MX = 4 * 16, CI_AB = 32 * 32, CI_PB = 16 * 32, CI_O = 32 * 32, CI_G = 32 * 88, CI_UP = 32 * 88, CI_D = 88 * 32;
constexpr int CI_EARLY = CI_IN + CI_PB, CI_ALL = CI_EARLY + CI_AB + CI_O + CI_G + CI_UP + CI_D;
__device__ __forceinline__ void convert_range(const ConvPtrs& P, int lo, int hi, int gw, int NGW, LAS float* scr, int lane) {
#define T_DECODE(IT, W_, N_, WT_, K_, RO_, K0_, N0_, MI_) do { int r_ = (IT); MI_ = 0; \
        if (r_ < CI_IN) { W_ = P.w_in; N_ = IND; WT_ = P.WinT; K_ = DM; RO_ = 0; K0_ = 64 * (r_ / 120); N0_ = 64 * (r_ % 120); MI_ = 1; break; } r_ -= CI_IN; \
        if (r_ < CI_PB) { W_ = P.w_pb; N_ = DM; WT_ = P.WpbT; K_ = PW; RO_ = 0; K0_ = 64 * (r_ / 32); N0_ = 64 * (r_ % 32); break; } r_ -= CI_PB; \
        if (r_ < CI_AB) { W_ = P.w_ab; N_ = DM; WT_ = P.WabT; K_ = DM; RO_ = 0; K0_ = 64 * (r_ / 32); N0_ = 64 * (r_ % 32); break; } r_ -= CI_AB; \
        if (r_ < CI_O) { W_ = P.w_out; N_ = DM; WT_ = P.WoT; K_ = DM; RO_ = 0; K0_ = 64 * (r_ / 32); N0_ = 64 * (r_ % 32); break; } r_ -= CI_O; \
        if (r_ < CI_G) { W_ = P.w_gate; N_ = FF; WT_ = P.WguT; K_ = DM; RO_ = 0; K0_ = 64 * (r_ / 88); N0_ = 64 * (r_ % 88); break; } r_ -= CI_G; \
        if (r_ < CI_UP) { W_ = P.w_up; N_ = FF; WT_ = P.WguT; K_ = DM; RO_ = FF; K0_ = 64 * (r_ / 88); N0_ = 64 * (r_ % 88); break; } r_ -= CI_UP; \
        { W_ = P.w_down; N_ = DM; WT_ = P.WdT; K_ = FF; RO_ = 0; K0_ = 64 * (r_ / 32); N0_ = 64 * (r_ % 32); } } while (0)
    const int kr = lane >> 4, nc = (lane & 15) * 4, cc = lane & 7;
    f32x4 va[16], vb[16];
    struct Desc { const float* W; bf16_t* WT; int N, K, RO, K0, N0, MI; };
    Desc da = {nullptr, nullptr, 0, 0, 0, 0, 0, 0}, db = da;
    int ita = lo + gw, itb = ita + NGW;
#define T_LOAD(V, D) do { _Pragma("unroll") for (int i = 0; i < 16; ++i) V[i] = __builtin_nontemporal_load((const f32x4*)(D.W + (size_t)(D.K0 + 4 * i + kr) * D.N + D.N0 + nc)); } while (0)
#define T_TOLDS(V) do { _Pragma("unroll") for (int i = 0; i < 16; ++i) { LAS float* sp = scr + (4 * i + kr) * 65 + nc; sp[0] = V[i][0]; sp[1] = V[i][1]; sp[2] = V[i][2]; sp[3] = V[i][3]; } } while (0)
#define T_FINISH(D) do { asm volatile("s_waitcnt lgkmcnt(0)" ::: "memory"); \
        _Pragma("unroll") for (int j = 0; j < 8; ++j) { const int n = (lane >> 3) + 8 * j; const LAS float* sp = scr + (8 * cc) * 65 + n; \
            u32x4 o; o.x = cvtpk(sp[0], sp[65]); o.y = cvtpk(sp[2 * 65], sp[3 * 65]); o.z = cvtpk(sp[4 * 65], sp[5 * 65]); o.w = cvtpk(sp[6 * 65], sp[7 * 65]); \
            const int orow = D.MI ? map_in_row(D.N0 + n) : (D.N0 + n); \
            *(u32x4*)(D.WT + (size_t)(D.RO + orow) * D.K + D.K0 + 8 * cc) = o; } \
        asm volatile("s_waitcnt lgkmcnt(0)" ::: "memory"); } while (0)
    if (ita < hi) { T_DECODE(ita, da.W, da.N, da.WT, da.K, da.RO, da.K0, da.N0, da.MI); T_LOAD(va, da); }
    if (itb < hi) { T_DECODE(itb, db.W, db.N, db.WT, db.K, db.RO, db.K0, db.N0, db.MI); T_LOAD(vb, db); }
    while (ita < hi) {
        { T_TOLDS(va); const Desc cur = da; ita += 2 * NGW;
          if (ita < hi) { T_DECODE(ita, da.W, da.N, da.WT, da.K, da.RO, da.K0, da.N0, da.MI); T_LOAD(va, da); }
          T_FINISH(cur); }
        if (itb < hi) { T_TOLDS(vb); const Desc cur = db; itb += 2 * NGW;
          if (itb < hi) { T_DECODE(itb, db.W, db.N, db.WT, db.K, db.RO, db.K0, db.N0, db.MI); T_LOAD(vb, db); }
          T_FINISH(cur); }
    }
#undef T_LOAD
#undef T_TOLDS
#undef T_FINISH
#undef T_DECODE
}

__device__ __forceinline__ float wave_sum(float v) {
#pragma unroll
    for (int o = 1; o < 64; o <<= 1) v += __shfl_xor(v, o);
    return v;
}
__device__ __forceinline__ float wave_max(float v) {
#pragma unroll
    for (int o = 1; o < 64; o <<= 1) v = fmaxf(v, __shfl_xor(v, o));
    return v;
}
__device__ __forceinline__ void ln_row(const float* src, const float* gam, const float* bet, float* dstF, bf16_t* dstB, int lane) {
    f32x4 v[8]; float s = 0.f;
#pragma unroll
    for (int j = 0; j < 8; ++j) { v[j] = *(const f32x4*)(src + 4 * lane + 256 * j); s += (v[j][0] + v[j][1]) + (v[j][2] + v[j][3]); }
    const float mean = wave_sum(s) * (1.f / DM); float q = 0.f;
#pragma unroll
    for (int j = 0; j < 8; ++j) { v[j] = v[j] - mean; q += (v[j][0] * v[j][0] + v[j][1] * v[j][1]) + (v[j][2] * v[j][2] + v[j][3] * v[j][3]); }
    const float rstd = 1.f / sqrtf(wave_sum(q) * (1.f / DM) + LN_EPS);
#pragma unroll
    for (int j = 0; j < 8; ++j) { const f32x4 g = *(const f32x4*)(gam + 4 * lane + 256 * j), b = *(const f32x4*)(bet + 4 * lane + 256 * j); const f32x4 o = v[j] * rstd * g + b;
        *(f32x4*)(dstF + 4 * lane + 256 * j) = o;
        if (dstB) { u32x2 w; w.x = cvtpk(o[0], o[1]); w.y = cvtpk(o[2], o[3]); *(u32x2*)(dstB + 4 * lane + 256 * j) = w; } }
}

__device__ __forceinline__ int crow(int r, int hi) { return (r & 3) + 8 * (r >> 2) + 4 * hi; }
__device__ __forceinline__ void attn_prompt_unit(LAS unsigned char* lds, int tid, int kvh, int qb, const bf16_t* Q, const bf16_t* Kb, const bf16_t* Vb, bf16_t* AO, const float* sinks) {
    const int lane = tid & 63, w = tid >> 6, q = lane & 31, hi = lane >> 5;
    const int q0 = qb * 32, kb0 = q0 - 128, head = kvh * 8 + w;
    LAS unsigned char* Ks = lds; LAS unsigned char* Vt = lds + 23040;
    bf16x8 qf[4]; const bf16_t* qp = Q + (size_t)(q0 + q) * DM + head * 64 + hi * 8;
#pragma unroll
    for (int dc = 0; dc < 4; ++dc) qf[dc] = *(const bf16x8*)(qp + 16 * dc);
    for (int it = tid; it < 1280; it += 512) {
        const int row = it >> 3, ch = it & 7, kp = kb0 + row;
        u32x4 kv = {0u, 0u, 0u, 0u}, vv = {0u, 0u, 0u, 0u};
        if (kp >= 0) { kv = *(const u32x4*)(Kb + (size_t)kp * KVD + kvh * 64 + ch * 8); vv = *(const u32x4*)(Vb + (size_t)kp * KVD + kvh * 64 + ch * 8); }
        *(LAS u32x4*)(Ks + row * 144 + ch * 16) = kv;
#pragma unroll
        for (int e = 0; e < 8; ++e) { const unsigned wv = vv[e >> 1]; *(LAS unsigned short*)(Vt + (8 * ch + e) * 328 + row * 2) = (unsigned short)((e & 1) ? (wv >> 16) : (wv & 0xffffu)); }
    }
    __syncthreads();
    f32x16 p[5];
#pragma unroll
    for (int j = 0; j < 5; ++j) {
        p[j] = (f32x16){0.f, 0.f, 0.f, 0.f, 0.f, 0.f, 0.f, 0.f, 0.f, 0.f, 0.f, 0.f, 0.f, 0.f, 0.f, 0.f};
#pragma unroll
        for (int dc = 0; dc < 4; ++dc) { const bf16x8 kf = *(const LAS bf16x8*)(Ks + (32 * j + q) * 144 + (16 * dc + 8 * hi) * 2); p[j] = __builtin_amdgcn_mfma_f32_32x32x16_bf16(kf, qf[dc], p[j], 0, 0, 0); }
    }
    const int qpos = q0 + q; float mx = -1e30f;
#pragma unroll
    for (int j = 0; j < 5; ++j)
#pragma unroll
        for (int r = 0; r < 16; ++r) { const int kp = kb0 + 32 * j + crow(r, hi); const bool vis = (kp >= 0) && (kp <= qpos) && (kp > qpos - 128);
            const float s = vis ? p[j][r] : -1e30f; p[j][r] = s; mx = fmaxf(mx, s); }
    mx = fmaxf(mx, __shfl_xor(mx, 32)); const float sk = sinks[head] * LOG2E; mx = fmaxf(mx, sk);
    float l = 0.f;
#pragma unroll
    for (int j = 0; j < 5; ++j)
#pragma unroll
        for (int r = 0; r < 16; ++r) { const float e = __builtin_amdgcn_exp2f(p[j][r] - mx); p[j][r] = e; l += e; }
    l += __shfl_xor(l, 32); const float inv = 1.f / (l + __builtin_amdgcn_exp2f(sk - mx));
    f32x16 o[2];
    o[0] = (f32x16){0.f, 0.f, 0.f, 0.f, 0.f, 0.f, 0.f, 0.f, 0.f, 0.f, 0.f, 0.f, 0.f, 0.f, 0.f, 0.f}; o[1] = o[0];
#pragma unroll
    for (int c = 0; c < 10; ++c) { const int j = c >> 1, h8 = (c & 1) * 8;
        u32x4 pw; pw.x = cvtpk(p[j][h8 + 0], p[j][h8 + 1]); pw.y = cvtpk(p[j][h8 + 2], p[j][h8 + 3]); pw.z = cvtpk(p[j][h8 + 4], p[j][h8 + 5]); pw.w = cvtpk(p[j][h8 + 6], p[j][h8 + 7]);
        const bf16x8 pa = __builtin_bit_cast(bf16x8, pw);
#pragma unroll
        for (int dh = 0; dh < 2; ++dh) { const LAS unsigned char* vp = Vt + (32 * dh + q) * 328 + (16 * c + 4 * hi) * 2;
            const u32x2 lo = *(const LAS u32x2*)vp, hh = *(const LAS u32x2*)(vp + 16); u32x4 vw; vw.x = lo.x; vw.y = lo.y; vw.z = hh.x; vw.w = hh.y;
            o[dh] = __builtin_amdgcn_mfma_f32_32x32x16_bf16(__builtin_bit_cast(bf16x8, vw), pa, o[dh], 0, 0, 0); } }
    bf16_t* op = AO + (size_t)(q0 + q) * DM + head * 64;
#pragma unroll
    for (int dh = 0; dh < 2; ++dh)
#pragma unroll
        for (int g4 = 0; g4 < 4; ++g4) { u32x2 wv; wv.x = cvtpk(o[dh][4 * g4] * inv, o[dh][4 * g4 + 1] * inv); wv.y = cvtpk(o[dh][4 * g4 + 2] * inv, o[dh][4 * g4 + 3] * inv);
            *(u32x2*)(op + 32 * dh + 8 * g4 + 4 * hi) = wv; }
    __syncthreads();
}
__device__ __forceinline__ void attn_sample_unit(LAS unsigned char* lds, int tid, int b, int kvh, const bf16_t* Q, const float* KS, const float* VS, bf16_t* AO, const float* sinks) {
    const int lane = tid & 63, w = tid >> 6;
    LAS float* Ksf = (LAS float*)lds; LAS float* Vsf = (LAS float*)(lds + 33280); LAS float* Qs = (LAS float*)(lds + 66048); LAS float* Ss = (LAS float*)(lds + 68096); LAS float* den = (LAS float*)(lds + 72192);
    for (int it = tid; it < 2048; it += 512) { const int key = it >> 4, ch = it & 15; const size_t off = ((size_t)(b * 128 + key)) * 256 + kvh * 64 + 4 * ch;
        const f32x4 kv = *(const f32x4*)(KS + off), vv = *(const f32x4*)(VS + off);
        LAS float* kd = Ksf + key * 65 + 4 * ch; kd[0] = kv[0]; kd[1] = kv[1]; kd[2] = kv[2]; kd[3] = kv[3];
        *(LAS f32x4*)(Vsf + key * 64 + 4 * ch) = vv; }
    { const int h = tid >> 6, d = tid & 63; Qs[h * 64 + d] = bf2f(Q[(size_t)(SEQ + b) * DM + (kvh * 8 + h) * 64 + d]); }
    __syncthreads();
    { const int key = tid & 127, hg = tid >> 7;
#pragma unroll
      for (int hh = 0; hh < 2; ++hh) { const int h = 2 * hg + hh; float s = 0.f;
#pragma unroll 16
          for (int d = 0; d < 64; ++d) s += Qs[h * 64 + d] * Ksf[key * 65 + d];
          Ss[h * 128 + key] = s; } }
    __syncthreads();
    { const int h = w; const float s0 = Ss[h * 128 + lane], s1 = Ss[h * 128 + 64 + lane]; const float sk = sinks[kvh * 8 + h] * LOG2E;
      const float m = fmaxf(wave_max(fmaxf(s0, s1)), sk); const float e0 = __builtin_amdgcn_exp2f(s0 - m), e1 = __builtin_amdgcn_exp2f(s1 - m);
      const float l = wave_sum(e0 + e1); Ss[h * 128 + lane] = e0; Ss[h * 128 + 64 + lane] = e1; if (lane == 0) den[h] = l + __builtin_amdgcn_exp2f(sk - m); }
    __syncthreads();
    { const int h = tid >> 6, d = tid & 63; float o = 0.f;
#pragma unroll 16
      for (int key = 0; key < 128; ++key) o += Ss[h * 128 + key] * Vsf[key * 64 + d];
      o = o / den[h];
      const unsigned pk = cvtpk(o, 0.f); AO[(size_t)(SEQ + b) * DM + (kvh * 8 + h) * 64 + d] = (bf16_t)(pk & 0xffffu); }
    __syncthreads();
}


__device__ __forceinline__ f32x2 thin_unit(LAS unsigned char* lds, int wave, int lane, const bf16_t* A, int lda, const bf16_t* Bt, int ldb, int K) {
    const int fr = lane & 15, fq = lane >> 4, kw = K >> 3;
    const bf16_t* ap = A + (size_t)fr * lda + wave * kw + 8 * fq;
    const bf16_t* bp = Bt + (size_t)fr * ldb + wave * kw + 8 * fq;
    const size_t a16 = (size_t)16 * lda, b16 = (size_t)16 * ldb;
    f32x4 acc[2][2];
#pragma unroll
    for (int i = 0; i < 2; ++i)
#pragma unroll
        for (int j = 0; j < 2; ++j) acc[i][j] = (f32x4){0.f, 0.f, 0.f, 0.f};
#pragma unroll 4
    for (int k = 0; k < kw; k += 64) {
        bf16x8 af[2][2], bfr[2][2];
#pragma unroll
        for (int i = 0; i < 2; ++i)
#pragma unroll
            for (int st = 0; st < 2; ++st) { af[i][st] = *(const bf16x8*)(ap + i * a16 + k + 32 * st); bfr[i][st] = *(const bf16x8*)(bp + i * b16 + k + 32 * st); }
#pragma unroll
        for (int st = 0; st < 2; ++st)
#pragma unroll
            for (int i = 0; i < 2; ++i)
#pragma unroll
                for (int j = 0; j < 2; ++j) acc[i][j] = __builtin_amdgcn_mfma_f32_16x16x32_bf16(af[i][st], bfr[j][st], acc[i][j], 0, 0, 0);
    }
    LAS float* part = (LAS float*)lds;
#pragma unroll
    for (int i = 0; i < 2; ++i)
#pragma unroll
        for (int j = 0; j < 2; ++j)
#pragma unroll
            for (int q = 0; q < 4; ++q) part[wave * 1024 + (16 * i + 4 * fq + q) * 32 + 16 * j + fr] = acc[i][j][q];
    __syncthreads();
    const int t = wave * 64 + lane; f32x2 o = {0.f, 0.f};
#pragma unroll
    for (int w = 0; w < 8; ++w) { const f32x2 v = *(const LAS f32x2*)(part + w * 1024 + (t >> 4) * 32 + 2 * (t & 15)); o += v; }
    __syncthreads();
    return o;
}

template <int W>
__device__ __forceinline__ void pool_item(const float* U, bf16_t* DP, int r0, int c) {
    f32x4 v[16 + W - 1];
#pragma unroll
    for (int i = 0; i < 16 + W - 1; ++i) { const int r = r0 - (W - 1) + i; u32x2 xw = {0u, 0u}; if (r >= 0) xw = *(const u32x2*)((const bf16_t*)U + (size_t)r * PW + c); v[i] = (f32x4){bflo(xw.x), bfhi(xw.x), bflo(xw.y), bfhi(xw.y)}; }
    f32x4 tot = {0.f, 0.f, 0.f, 0.f};
#pragma unroll
    for (int i = 0; i < W - 1; ++i) tot += v[i];
#pragma unroll
    for (int i = 0; i < 16; ++i) { const int r = r0 + i; tot += v[W - 1 + i]; const float rc = 1.f / (float)(r + 1 < W ? r + 1 : W); const f32x4 d = tot * rc - v[W - 1 + i];
        u32x2 w; w.x = cvtpk(d[0], d[1]); w.y = cvtpk(d[2], d[3]); *(u32x2*)(DP + (size_t)r * DM + c) = w; tot -= v[i]; }
}

__device__ __forceinline__ float gelu_tanh(float x) {
    const float z = 0.7978845608028654f * (x + 0.044715f * x * x * x);
    const float t = __builtin_amdgcn_exp2f(2.885390081777927f * z);
    const float th = 1.f - 2.f * __builtin_amdgcn_rcpf(t + 1.f);
    return 0.5f * x * (1.f + th);
}


#define XB_TMO      128
#define XB_XCNT(j)  (256  + 64 * (j))
#define XB_XSUB(j)  (1280 + 64 * (j))
#define XB_XGEN(j)  (2304 + 64 * (j))
#define XB_TOP      3328
#define XB_TOPGEN   3392
#define XCD_BAR_WORDS 3456
#define XB_SPIN_CAP (1u << 18)
__device__ __forceinline__ unsigned xb_ld(unsigned* p)              { return __hip_atomic_load(p, __ATOMIC_RELAXED, __HIP_MEMORY_SCOPE_AGENT); }
__device__ __forceinline__ unsigned xb_add(unsigned* p, unsigned v) { return __hip_atomic_fetch_add(p, v, __ATOMIC_RELAXED, __HIP_MEMORY_SCOPE_AGENT); }
__device__ __forceinline__ unsigned xb_xcc_id() { return (unsigned)__builtin_amdgcn_s_getreg((3 << 11) | 20) & 0xFu; }
#define XB_SPIN(cond, bar) do { unsigned _sp = 0; while (cond) { __builtin_amdgcn_s_sleep(1); \
    if ((++_sp & 255u) == 0u) { if (xb_ld(&(bar)[XB_TMO])) break; if (_sp > XB_SPIN_CAP) { atomicAdd(&(bar)[XB_TMO], 1u); break; } } } } while (0)
struct XcdBarrier { unsigned* bar; unsigned x; volatile LAS unsigned* st; };
__device__ __forceinline__ void xcd_barrier_complete(unsigned* bar, unsigned x, unsigned& nloc, unsigned& nx) {
    const unsigned G = gridDim.x * gridDim.y * gridDim.z;
    unsigned sum, cnt, mine, sp = 0u;
    for (;;) {
        sum = 0u; cnt = 0u; mine = 0u;
#pragma unroll
        for (unsigned j = 0; j < 16; ++j) { const unsigned c = xb_ld(&bar[XB_XCNT(j)]); sum += c; cnt += (c > 0u) ? 1u : 0u; mine = (j == x) ? c : mine; }
        if (sum == G) break;
        __builtin_amdgcn_s_sleep(1);
        if ((++sp & 255u) == 0u) { if (xb_ld(&bar[XB_TMO])) break; if (sp > XB_SPIN_CAP) { atomicAdd(&bar[XB_TMO], 1u); break; } }
    }
    nloc = mine > 0u ? mine : 1u; nx = cnt > 0u ? cnt : 1u;
}
__device__ __forceinline__ void xcd_barrier(const XcdBarrier& b, bool t0) {
    asm volatile("s_waitcnt vmcnt(0)" ::: "memory");
    __syncthreads();
    if (t0) {
        unsigned* bar = b.bar;
        __builtin_amdgcn_s_waitcnt(0);
        unsigned nloc = b.st[0], nx = b.st[1];
        if (nloc == 0u) { xcd_barrier_complete(bar, b.x, nloc, nx); b.st[0] = nloc; b.st[1] = nx; }
        const unsigned old = xb_add(&bar[XB_XSUB(b.x)], 1u);
        const unsigned gen = old / nloc;
        if (old + 1u == (gen + 1u) * nloc) {
            __builtin_amdgcn_fence(__ATOMIC_RELEASE, "agent");
            asm volatile("s_waitcnt vmcnt(0)" ::: "memory");
            const unsigned og = xb_add(&bar[XB_TOP], 1u);
            const unsigned tg = og / nx;
            if (og + 1u == (tg + 1u) * nx) xb_add(&bar[XB_TOPGEN], 1u);
            else XB_SPIN(xb_ld(&bar[XB_TOPGEN]) == tg, bar);
            __builtin_amdgcn_fence(__ATOMIC_ACQUIRE, "agent");
            xb_add(&bar[XB_XGEN(b.x)], 1u);
            asm volatile("s_waitcnt vmcnt(0)" ::: "memory");
        } else {
            XB_SPIN(xb_ld(&bar[XB_XGEN(b.x)]) == gen, bar);
            __builtin_amdgcn_fence(__ATOMIC_ACQUIRE, "agent");
            asm volatile("s_waitcnt vmcnt(0)" ::: "memory");
        }
    }
    __syncthreads();
}

struct Args { const float* in[22]; float* out; unsigned char* ws; };

__global__ void __launch_bounds__(512, 2) mega_fwd(Args a) {
    extern __shared__ __attribute__((aligned(16))) unsigned char lds_raw[];
    LAS unsigned char* lds = (LAS unsigned char*)lds_raw;
    cg::grid_group grid = cg::this_grid();
    const int wave = __builtin_amdgcn_readfirstlane(threadIdx.x >> 6), G = gridDim.x, bx = blockIdx.x;
    const int gw = bx * 8 + wave, NGW = G * 8;
    const size_t NGT = (size_t)G * 512;
    volatile LAS unsigned* MISC = (volatile LAS unsigned*)(lds + LDS_BYTES - 64);
    if (threadIdx.x < 16) MISC[threadIdx.x] = 0u;
    __syncthreads();
    XcdBarrier xbar; xbar.bar = (unsigned*)(a.ws + WS_CTL); xbar.x = xb_xcc_id(); xbar.st = MISC;
    if (threadIdx.x == 0) (void)xb_add(&xbar.bar[XB_XCNT(xbar.x)], 1u);
    if (G == 0x7fffffff) grid.sync();
#define GRID_SYNC() xcd_barrier(xbar, wave == 0 && lane_fresh() == 0)
#define FRESH_IDS const int lane = lane_fresh(); const int tid = wave * 64 + lane; const size_t gt = (size_t)bx * 512 + tid; (void)gt; (void)tid;
    unsigned char* ws = a.ws; float* out = a.out;
    const float* x_p = a.in[0]; const float* x_s = a.in[1]; const float* cache_k = a.in[2]; const float* cache_v = a.in[3]; const float* st_pool = a.in[4]; const float* st_conv = a.in[5];
    const float* w_in = a.in[6]; const float* sinks = a.in[7]; const float* w_mix = a.in[8]; const float* pool_scale = a.in[9]; const float* w_ab = a.in[10]; const float* w_pb = a.in[11];
    const float* w_out = a.in[12]; const float* ln1g = a.in[13]; const float* ln1b = a.in[14]; const float* w_up = a.in[15]; const float* w_gate = a.in[16]; const float* conv_w = a.in[17];
    const float* conv_b = a.in[18]; const float* w_down = a.in[19]; const float* ln2g = a.in[20]; const float* ln2b = a.in[21];
    bf16_t* WguT = (bf16_t*)(ws + WS_WGU); bf16_t* WdT = (bf16_t*)(ws + WS_WD); bf16_t* R1 = (bf16_t*)(ws + WS_R1);
    bf16_t* WinT = (bf16_t*)(ws + WS_WIN); bf16_t* WabT = (bf16_t*)(ws + WS_WAB); bf16_t* WpbT = (bf16_t*)(ws + WS_WPB); bf16_t* WmixT = (bf16_t*)(ws + WS_WMIX); bf16_t* WoT = (bf16_t*)(ws + WS_WO);
    bf16_t* R2 = (bf16_t*)(ws + WS_R2); float* U = (float*)(ws + WS_U); unsigned short* SG = (unsigned short*)(ws + WS_SG); float* H1 = (float*)(ws + WS_SG);
    bf16_t* Kb = (bf16_t*)(ws + WS_KB); bf16_t* Vb = (bf16_t*)(ws + WS_VB); bf16_t* DP = (bf16_t*)(ws + WS_DP); bf16_t* PY = (bf16_t*)(ws + WS_PY);
    float* COS = (float*)(ws + WS_COS); float* SIN = (float*)(ws + WS_SIN); bf16_t* GU = (bf16_t*)(ws + WS_GU); bf16_t* UB = GU + (size_t)MP * FF;
    const ConvPtrs CP{w_in, w_mix, w_ab, w_pb, w_out, w_gate, w_up, w_down, WinT, WmixT, WabT, WpbT, WoT, WguT, WdT};
    float* Y = out + O_Y;

    {
        FRESH_IDS
        LAS float* scr = (LAS float*)(lds + wave * 16640);
        convert_range(CP, 0, CI_EARLY, gw, NGW, scr, lane);
        for (size_t i0 = gt; i0 < (size_t)MP * DM / 8; i0 += 4 * NGT) {
            f32x4 a0[4], a1[4];
#pragma unroll
            for (int u = 0; u < 4; ++u) { const size_t e = (i0 + u * NGT) * 8; const int r = (int)(e / DM), c = (int)(e % DM); a0[u] = (f32x4){0.f, 0.f, 0.f, 0.f}; a1[u] = a0[u];
                if (r < MR) { const float* src = r < SEQ ? x_p + (size_t)r * DM + c : x_s + (size_t)(r - SEQ) * DM + c; a0[u] = __builtin_nontemporal_load((const f32x4*)src); a1[u] = __builtin_nontemporal_load((const f32x4*)(src + 4)); } }
#pragma unroll
            for (int u = 0; u < 4; ++u) { const size_t e = (i0 + u * NGT) * 8; if (e < (size_t)MP * DM) { u32x4 w; w.x = cvtpk(a0[u][0], a0[u][1]); w.y = cvtpk(a0[u][2], a0[u][3]); w.z = cvtpk(a1[u][0], a1[u][1]); w.w = cvtpk(a1[u][2], a1[u][3]);
                *(u32x4*)(R1 + e) = w; } }
        }
        for (size_t i = gt; i < (size_t)4 * 256 * 256 / 8; i += NGT) { const size_t e = i * 8; const int g = (int)(e >> 16), d = (int)(e & 255);
            const f32x4 a0 = *(const f32x4*)(w_mix + e), a1 = *(const f32x4*)(w_mix + e + 4), s0 = *(const f32x4*)(pool_scale + 256 * g + d), s1 = *(const f32x4*)(pool_scale + 256 * g + d + 4);
            const f32x4 p0 = a0 * s0, p1 = a1 * s1; u32x4 w; w.x = cvtpk(p0[0], p0[1]); w.y = cvtpk(p0[2], p0[3]); w.z = cvtpk(p1[0], p1[1]); w.w = cvtpk(p1[2], p1[3]); *(u32x4*)(WmixT + e) = w; }
        for (size_t i = gt; i < (size_t)(SEQ + 1) * 32; i += NGT) { const int pos = (int)(i >> 5), j = (int)(i & 31);
            const double inv = exp2(-(double)j * (13.287712379549449 / 32.0)); const double ang = (double)pos * inv; COS[i] = (float)cos(ang); SIN[i] = (float)sin(ang); }
    }
    GRID_SYNC();

    {
        if ((bx & 1) == 0) { FRESH_IDS convert_range(CP, CI_EARLY, G == 256 ? CI_ALL - CI_D : CI_ALL, gw, NGW, (LAS float*)(lds + wave * 16640), lane);
        const size_t gt2 = (size_t)(bx >> 1) * 512 + tid, NGT2 = (size_t)((G + 1) >> 1) * 512; (void)gt2;
        for (size_t i0 = gt2; i0 < (size_t)NSMP * 127 * 64; i0 += 4 * NGT2) {
            f32x4 kk[4], vv[4];
#pragma unroll
            for (int u = 0; u < 4; ++u) { const size_t i = i0 + u * NGT2; if (i < (size_t)NSMP * 127 * 64) { const size_t b = i / (127 * 64), rem = i % (127 * 64); const size_t so = (b * 128 + 1) * 256 + rem * 4;
                kk[u] = __builtin_nontemporal_load((const f32x4*)(cache_k + so)); } }
#pragma unroll
            for (int u = 0; u < 4; ++u) { const size_t i = i0 + u * NGT2; if (i < (size_t)NSMP * 127 * 64) { const size_t b = i / (127 * 64), rem = i % (127 * 64); const size_t dof = b * 128 * 256 + rem * 4;
                *(f32x4*)(out + O_KS + dof) = kk[u]; } }
        }
        for (size_t i = gt2; i < (size_t)NSMP * 14 * 256; i += NGT2) { const size_t b = i / (14 * 256), rem = i % (14 * 256);
            *(f32x4*)(out + O_PS + b * 15 * PW + rem * 4) = *(const f32x4*)(st_pool + (b * 15 + 1) * PW + rem * 4); }
            __syncthreads(); }
        { pg8::Gemm g{R1, WinT, DM, DM, DM, 0}; pg8::StaticOrder S; S.init(MP, IND, G, bx);
          EpiIn E{R2, Kb, Vb, U, SG, COS, SIN, out};
          pg8::gemm_phase<EpiIn>(lds, g, S, E, wave); }
        { const int first = (G == 256) ? 222 : 0;
          if (bx >= first && bx < first + 32) { pg8::Gemm g{WpbT, WmixT, 256, PW, 256, 256}; pg8::StaticOrder S; S.init(DM, PW, 32, bx - first); EpiWeff E{PY}; pg8::gemm_phase<EpiWeff>(lds, g, S, E, wave); } }
        if ((bx & 1) != 0) { FRESH_IDS convert_range(CP, CI_EARLY, G == 256 ? CI_ALL - CI_D : CI_ALL, gw, NGW, (LAS float*)(lds + wave * 16640), lane);
        const size_t gt2 = (size_t)(bx >> 1) * 512 + tid, NGT2 = (size_t)((G + 1) >> 1) * 512; (void)gt2;
        for (size_t i0 = gt2; i0 < (size_t)NSMP * 127 * 64; i0 += 4 * NGT2) {
            f32x4 kk[4], vv[4];
#pragma unroll
            for (int u = 0; u < 4; ++u) { const size_t i = i0 + u * NGT2; if (i < (size_t)NSMP * 127 * 64) { const size_t b = i / (127 * 64), rem = i % (127 * 64); const size_t so = (b * 128 + 1) * 256 + rem * 4;
                 vv[u] = __builtin_nontemporal_load((const f32x4*)(cache_v + so)); } }
#pragma unroll
            for (int u = 0; u < 4; ++u) { const size_t i = i0 + u * NGT2; if (i < (size_t)NSMP * 127 * 64) { const size_t b = i / (127 * 64), rem = i % (127 * 64); const size_t dof = b * 128 * 256 + rem * 4;
                 *(f32x4*)(out + O_VS + dof) = vv[u]; } }
        }
        for (size_t i = gt2; i < (size_t)NSMP * (FF / 4); i += NGT2) { const size_t b = i / (FF / 4), rem = i % (FF / 4);
            *(f32x4*)(out + O_CS + b * 2 * FF + rem * 4) = *(const f32x4*)(st_conv + (b * 2 + 1) * FF + rem * 4); }
        }
    }
    GRID_SYNC();

    {
        FRESH_IDS
        bf16_t* AO = R1;
        for (int id = bx; id < 1024; id += G) attn_prompt_unit(lds, tid, id & 3, id >> 2, R2, Kb, Vb, AO, sinks);
        for (int id = bx; id < 512; id += G) attn_sample_unit(lds, tid, id >> 2, id & 3, R2, out + O_KS, out + O_VS, AO, sinks);
        const size_t NPI = (size_t)(SEQ / 16) * 256, NSI = (size_t)NSMP * 256;
        for (size_t it = gt; it < NPI + NSI; it += NGT) {
            if (it < NPI) {
                const int rb = (int)(it >> 8), c = (int)(it & 255) * 4, g = c >> 8, r0 = rb * 16;
                if (g == 0) pool_item<2>(U, DP, r0, c); else if (g == 1) pool_item<4>(U, DP, r0, c); else if (g == 2) pool_item<8>(U, DP, r0, c); else pool_item<16>(U, DP, r0, c);
            } else {
                const size_t k = it - NPI; const int b = (int)(k >> 8), c = (int)(k & 255) * 4, wdw = 2 << (c >> 8), r = SEQ + b;
                const u32x2 xw = *(const u32x2*)((const bf16_t*)U + (size_t)r * PW + c); const f32x4 cur = {bflo(xw.x), bfhi(xw.x), bflo(xw.y), bfhi(xw.y)}; f32x4 tot = cur;
                for (int j = 1; j < wdw; ++j) tot += *(const f32x4*)(st_pool + ((size_t)b * 15 + (15 - j)) * PW + c);
                const f32x4 d = tot * (1.f / (float)wdw) - cur;
                u32x2 w; w.x = cvtpk(d[0], d[1]); w.y = cvtpk(d[2], d[3]); *(u32x2*)(DP + (size_t)r * DM + c) = w;
            }
        }
    }
    GRID_SYNC();

    {
        { pg8::Gemm g0{DP, PY  , PW, DM, DM, 0}; pg8::Gemm g1{R1  , WabT, DM, DM, DM, 0}; pg8::StaticOrder S; S.init(SEQ, DM, G, bx); EpiBr E{SG, R2}; pg8::gemm_phase2<EpiBr>(lds, g0, g1, S, E, wave); }
        { FRESH_IDS
          for (int id = bx; id < 256; id += G) { const int r0 = SEQ + 32 * (id & 3), c0 = 32 * (id >> 2);
              const f32x2 va = thin_unit(lds, wave, lane, DP + (size_t)r0 * DM, DM, PY + (size_t)c0 * DM, DM, PW);
              const f32x2 vb = thin_unit(lds, wave, lane, R1 + (size_t)r0 * DM, DM, WabT + (size_t)c0 * DM, DM, DM);
              const int r = r0 + (tid >> 4), c = c0 + 2 * (tid & 15);
              const unsigned gp = *(const unsigned*)(SG + (size_t)r * 4096 + c), ga = *(const unsigned*)(SG + (size_t)r * 4096 + 2048 + c);
              *(unsigned*)(R2 + (size_t)r * DM + c) = cvtpk((hlo(gp) * va[0] + vb[0]) * hlo(ga), (hhi(gp) * va[1] + vb[1]) * hhi(ga)); } }
    }
    GRID_SYNC();

    {
        unsigned* ctl = (unsigned*)(ws + WS_CTL); float* rs1 = (float*)(ctl + CW_RS1);
        if (G == 256) { pg8::Gemm g{R2, WoT, DM, DM, DM, 0}; pg8::StaticOrder S; S.init(SEQ, DM, G, bx); EpiOutLN E{x_p, Y, R1, lds + 131072, rs1, ctl + CW_CNT, ln1g, ln1b}; pg8::gemm_phase<EpiOutLN>(lds, g, S, E, wave); }
        { FRESH_IDS
          if (G == 256) { const int id = bx; const int r0 = SEQ + 32 * (id & 3), c0 = 32 * (id >> 2);
              const f32x2 v = thin_unit(lds, wave, lane, R2 + (size_t)r0 * DM, DM, WoT + (size_t)c0 * DM, DM, DM);
              const int r = r0 + (tid >> 4), c = c0 + 2 * (tid & 15);
              const f32x2 xv = *(const f32x2*)(x_s + (size_t)(r - SEQ) * DM + c);
              const f32x2 z = ln_thin(xv * ALPHA + v, r, tid, (float*)(ctl + CW_TS1), ctl + CW_CNT + 2048 + 64 * (id & 3));
              const f32x2 o = z * *(const f32x2*)(ln1g + c) + *(const f32x2*)(ln1b + c);
              *(f32x2*)(Y + (size_t)r * DM + c) = o; *(unsigned*)(R1 + (size_t)r * DM + c) = cvtpk(o[0], o[1]); } }
    }
    GRID_SYNC();

    {
        pg8::Gemm g{R1, WguT, DM, DM, DM, 0}; pg8::StaticOrder S; S.init(MP, 2 * FF, G, bx, 3); EpiGU E{GU, out}; pg8::gemm_phase<EpiGU>(lds, g, S, E, wave);
        if (G == 256 && bx >= 172) { FRESH_IDS convert_range(CP, CI_ALL - CI_D, CI_ALL, gw - 172 * 8, 84 * 8, (LAS float*)(lds + wave * 16640), lane); }
    }
    GRID_SYNC();

    { FRESH_IDS
      const size_t NPI = (size_t)(SEQ / 8) * (FF / 8), NSI = (size_t)NSMP * (FF / 8);
      for (size_t it = gt; it < NPI + NSI; it += NGT) {
          const bool smp = it >= NPI; const size_t k = smp ? it - NPI : it;
          const int rb = (int)(k / (FF / 8)), c = (int)(k % (FF / 8)) * 8;
          f32x4 cw[3][2], cb[2];
#pragma unroll
          for (int h = 0; h < 2; ++h) { cb[h] = *(const f32x4*)(conv_b + c + 4 * h);
#pragma unroll
              for (int j = 0; j < 3; ++j) cw[j][h] = *(const f32x4*)(conv_w + (size_t)j * FF + c + 4 * h); }
          if (!smp) {
              const int r0 = rb * 8; u32x4 gw_[10], uw[8];
#pragma unroll
              for (int i = 0; i < 10; ++i) { const int r = r0 - 2 + i; gw_[i] = r >= 0 ? *(const u32x4*)(GU + (size_t)r * FF + c) : (u32x4){0u, 0u, 0u, 0u}; }
#pragma unroll
              for (int i = 0; i < 8; ++i) uw[i] = *(const u32x4*)(UB + (size_t)(r0 + i) * FF + c);
#pragma unroll
              for (int i = 0; i < 8; ++i) { u32x4 wo;
#pragma unroll
                  for (int h = 0; h < 2; ++h) {
                      const f32x4 g0 = {bflo(gw_[i][2 * h]), bfhi(gw_[i][2 * h]), bflo(gw_[i][2 * h + 1]), bfhi(gw_[i][2 * h + 1])};
                      const f32x4 g1 = {bflo(gw_[i + 1][2 * h]), bfhi(gw_[i + 1][2 * h]), bflo(gw_[i + 1][2 * h + 1]), bfhi(gw_[i + 1][2 * h + 1])};
                      const f32x4 g2 = {bflo(gw_[i + 2][2 * h]), bfhi(gw_[i + 2][2 * h]), bflo(gw_[i + 2][2 * h + 1]), bfhi(gw_[i + 2][2 * h + 1])};
                      const f32x4 up = {bflo(uw[i][2 * h]), bfhi(uw[i][2 * h]), bflo(uw[i][2 * h + 1]), bfhi(uw[i][2 * h + 1])};
                      const f32x4 y = cb[h] + cw[0][h] * g0 + cw[1][h] * g1 + cw[2][h] * g2;
                      const f32x4 hv = {gelu_tanh(y[0]) * up[0], gelu_tanh(y[1]) * up[1], gelu_tanh(y[2]) * up[2], gelu_tanh(y[3]) * up[3]};
                      wo[2 * h] = cvtpk(hv[0], hv[1]); wo[2 * h + 1] = cvtpk(hv[2], hv[3]); }
                  *(u32x4*)(UB + (size_t)(r0 + i) * FF + c) = wo; }
          } else {
              const int r = SEQ + rb; const float* h0 = st_conv + (size_t)rb * 2 * FF + c;
              const u32x4 gwv = *(const u32x4*)(GU + (size_t)r * FF + c), uwv = *(const u32x4*)(UB + (size_t)r * FF + c); u32x4 wo;
#pragma unroll
              for (int h = 0; h < 2; ++h) {
                  const f32x4 g0 = *(const f32x4*)(h0 + 4 * h), g1 = *(const f32x4*)(h0 + FF + 4 * h);
                  const f32x4 g2 = {bflo(gwv[2 * h]), bfhi(gwv[2 * h]), bflo(gwv[2 * h + 1]), bfhi(gwv[2 * h + 1])};
                  const f32x4 up = {bflo(uwv[2 * h]), bfhi(uwv[2 * h]), bflo(uwv[2 * h + 1]), bfhi(uwv[2 * h + 1])};
                  const f32x4 y = cb[h] + cw[0][h] * g0 + cw[1][h] * g1 + cw[2][h] * g2;
                  const f32x4 hv = {gelu_tanh(y[0]) * up[0], gelu_tanh(y[1]) * up[1], gelu_tanh(y[2]) * up[2], gelu_tanh(y[3]) * up[3]};
                  wo[2 * h] = cvtpk(hv[0], hv[1]); wo[2 * h + 1] = cvtpk(hv[2], hv[3]); }
              *(u32x4*)(UB + (size_t)r * FF + c) = wo;
          }
      } }
    GRID_SYNC();

    {
        unsigned* ctl = (unsigned*)(ws + WS_CTL); float* rs2 = (float*)(ctl + CW_RS2);
        if (G == 256) { pg8::Gemm g{UB, WdT, FF, FF, FF, 0}; pg8::StaticOrder S; S.init(SEQ, DM, G, bx); EpiDownLN E{Y, R1, lds + 131072, rs2, ctl + CW_CNT + 4096, ln2g, ln2b}; pg8::gemm_phase<EpiDownLN>(lds, g, S, E, wave); }
        { FRESH_IDS
          if (G == 256) { const int id = bx; const int r0 = SEQ + 32 * (id & 3), c0 = 32 * (id >> 2);
              const f32x2 v = thin_unit(lds, wave, lane, UB + (size_t)r0 * FF, FF, WdT + (size_t)c0 * FF, FF, FF);
              const int r = r0 + (tid >> 4), c = c0 + 2 * (tid & 15);
              float* yp = Y + (size_t)r * DM + c;
              const f32x2 z = ln_thin(*(const f32x2*)yp * ALPHA + v, r, tid, (float*)(ctl + CW_TS2), ctl + CW_CNT + 6144 + 64 * (id & 3));
              *(f32x2*)yp = z * *(const f32x2*)(ln2g + c) + *(const f32x2*)(ln2b + c); } }
    }
}

extern "C" void kernel_launch(void* const* d_in, const int* in_sizes, int n_in, void* d_out, int out_size, void* d_ws, size_t ws_size, hipStream_t stream) {
    static int grid = 0;
    if (grid == 0) {
        if (n_in != 22 || ws_size < WS_TOTAL) { fprintf(stderr, "kernel_launch: need 22 inputs and >= %zu bytes of workspace (got %d, %zu)\n", (size_t)WS_TOTAL, n_in, ws_size); grid = -1; return; }
        int dev = 0, cus = 0, per_cu = 0;
        (void)hipGetDevice(&dev); (void)hipDeviceGetAttribute(&cus, hipDeviceAttributeMultiprocessorCount, dev);
        (void)hipFuncSetAttribute((const void*)mega_fwd, hipFuncAttributeMaxDynamicSharedMemorySize, LDS_BYTES);
        if (hipOccupancyMaxActiveBlocksPerMultiprocessor(&per_cu, (const void*)mega_fwd, 512, LDS_BYTES) != hipSuccess || per_cu < 1) { fprintf(stderr, "kernel_launch: occupancy query says %d blocks per CU\n", per_cu); per_cu = 1; }
        (void)hipGetLastError();
        grid = cus;
    }
    if (grid < 0) return;
    (void)hipMemsetAsync((char*)d_ws + WS_CTL, 0, CTL_BYTES, stream);
    Args a{};
    for (int i = 0; i < 22; ++i) a.in[i] = (const float*)d_in[i];
    a.out = (float*)d_out; a.ws = (unsigned char*)d_ws;
    void* args[] = {&a};
    hipError_t e = hipLaunchCooperativeKernel((const void*)mega_fwd, dim3(grid), dim3(512), args, LDS_BYTES, stream);
    if (e != hipSuccess) fprintf(stderr, "cooperative launch failed: %s (grid %d)\n", hipGetErrorString(e), grid);
}
```
